# Optimizing an MI355X kernel written in HIP

```python
import jax
import jax.numpy as jnp
from jax import lax
import numpy as np

D_MODEL = 1024
BATCH = 32
SEQ = 2048
DEPTH = 2

NSA_HEADS = 8
NSA_GROUPS = 2
NSA_REP = NSA_HEADS // NSA_GROUPS
NSA_DH = 64
NSA_WIDTH = NSA_HEADS * NSA_DH
NSA_KV_WIDTH = NSA_GROUPS * NSA_DH
CMP_LEN = 32
CMP_STRIDE = 16
CMP_HIDDEN = 2 * NSA_DH
SEL_LEN = 64
SEL_TOPK = 8
FORCE_SCORE = 1.0e4
WINDOW = 512
Q_BLOCK = 128
HGRN_HEADS = 4
HGRN_DK = 128
HGRN_DV = 128
HGRN_WIDTH = HGRN_HEADS * HGRN_DK
HGRN_VWIDTH = HGRN_HEADS * HGRN_DV
HGRN_CHUNK = 64
MLP_HIDDEN = 4 * D_MODEL
ROPE_THETA = 10000.0
LN_EPS = 1e-5
RMS_EPS = 1e-6
DEEPNORM_ALPHA = (2 * DEPTH) ** 0.25
DEEPNORM_BETA = (8 * DEPTH) ** -0.25
IN_SIZES = (NSA_WIDTH,) + (NSA_KV_WIDTH,) * 6 + (3 * NSA_HEADS,) + (HGRN_WIDTH, HGRN_WIDTH, HGRN_VWIDTH, HGRN_VWIDTH) + (D_MODEL, D_MODEL)
IN_OFFSETS = [int(v) for v in np.cumsum(IN_SIZES)[:-1]]
N_IN = int(sum(IN_SIZES))

kernel_name = 'hybrid_nsa_hgrn2_deepnorm_adaln'


def layer_norm(x, g, b):
    xf = x.astype(jnp.float32)
    mu = jnp.mean(xf, axis=-1, keepdims=True)
    var = jnp.mean(jnp.square(xf - mu), axis=-1, keepdims=True)
    y = (xf - mu) * lax.rsqrt(var + LN_EPS) * g.astype(jnp.float32) + b.astype(jnp.float32)
    return y.astype(x.dtype)


def masked_softmax(s, mask):
    s = jnp.where(mask, s.astype(jnp.float32), -jnp.inf)
    m = jnp.max(s, axis=-1, keepdims=True)
    m = jnp.where(jnp.isfinite(m), m, 0.0)
    e = jnp.where(mask, jnp.exp(s - m), 0.0)
    return e / jnp.maximum(jnp.sum(e, axis=-1, keepdims=True), 1e-30)


def rope_tables(S, dim, dtype):
    inv = 1.0 / (ROPE_THETA ** (jnp.arange(0, dim, 2, dtype=jnp.float32) / dim))
    ang = jnp.arange(S, dtype=jnp.float32)[:, None] * inv[None, :]
    return jnp.cos(ang).astype(dtype), jnp.sin(ang).astype(dtype)


def apply_rope(t, cos, sin):
    half = t.shape[-1] // 2
    t1, t2 = t[..., :half], t[..., half:]
    return jnp.concatenate([t1 * cos - t2 * sin, t2 * cos + t1 * sin], axis=-1)


def nsa_mixer(q, k_c, v_c, k_s, v_s, k_w, v_w, gate_logits, pe_k, pe_v, wk1, wk2, wv1, wv2):
    B, S, _ = q.shape
    dt = q.dtype
    G, R, dh = NSA_GROUPS, NSA_REP, NSA_DH
    scale = dh ** -0.5
    cos, sin = rope_tables(S, dh, dt)
    qh = apply_rope(q.reshape(B, S, G, R, dh).transpose(0, 2, 3, 1, 4), cos, sin)

    def kv_heads(t):
        return t.reshape(B, S, G, dh).transpose(0, 2, 1, 3)

    kc = apply_rope(kv_heads(k_c), cos, sin)
    vc = kv_heads(v_c)
    ks = apply_rope(kv_heads(k_s), cos, sin)
    vs = kv_heads(v_s)
    kw = apply_rope(kv_heads(k_w), cos, sin)
    vw = kv_heads(v_w)
    pos = np.arange(S)

    nc = (S - CMP_LEN) // CMP_STRIDE + 1
    cstart = np.arange(nc) * CMP_STRIDE
    cidx = cstart[:, None] + np.arange(CMP_LEN)[None, :]

    def compress(t, pe, w1, w2):
        blk = (t[:, :, cidx] + pe).reshape(B, G, nc, CMP_LEN * dh)
        return jax.nn.silu(blk @ w1) @ w2

    kcc = compress(kc, pe_k, wk1, wk2)
    vcc = compress(vc, pe_v, wv1, wv2)
    mask_c = jnp.asarray(cstart[None, :] + CMP_LEN - 1 <= pos[:, None])
    p_c = masked_softmax(jnp.einsum('bgrtd,bgnd->bgrtn', qh, kcc) * scale, mask_c)
    o_c = jnp.einsum('bgrtn,bgnd->bgrtd', p_c.astype(dt), vcc)

    nb = S // SEL_LEN
    sstart = np.arange(nb) * SEL_LEN
    overlap = ((cstart[:, None] < sstart[None, :] + SEL_LEN) & (cstart[:, None] + CMP_LEN > sstart[None, :])).astype(np.float32)
    imp = jnp.einsum('bgrtn,nj->bgtj', p_c, jnp.asarray(overlap))
    tb = pos // SEL_LEN
    jb = np.arange(nb)
    valid = jb[None, :] <= tb[:, None]
    forced = valid & ((jb[None, :] == 0) | (jb[None, :] == tb[:, None]) | (jb[None, :] == tb[:, None] - 1))
    score = jnp.where(jnp.asarray(forced), FORCE_SCORE, jnp.where(jnp.asarray(valid), imp, -1.0))
    n_sel = min(SEL_TOPK, nb)
    _, sel_idx = lax.top_k(score, n_sel)

    ks_blocks = ks.reshape(B, G, nb, SEL_LEN, dh)
    vs_blocks = vs.reshape(B, G, nb, SEL_LEN, dh)
    kw_pad = jnp.pad(kw, ((0, 0), (0, 0), (WINDOW, 0), (0, 0)))
    vw_pad = jnp.pad(vw, ((0, 0), (0, 0), (WINDOW, 0), (0, 0)))
    b_ix = jnp.arange(B)[:, None, None, None]
    g_ix = jnp.arange(G)[None, :, None, None]

    def block_fn(qb):
        s0 = qb * Q_BLOCK
        tq = s0 + jnp.arange(Q_BLOCK)
        qblk = lax.dynamic_slice_in_dim(qh, s0, Q_BLOCK, axis=3)
        idx = lax.dynamic_slice_in_dim(sel_idx, s0, Q_BLOCK, axis=2)
        kg = ks_blocks[b_ix, g_ix, idx]
        vg = vs_blocks[b_ix, g_ix, idx].reshape(B, G, Q_BLOCK, n_sel * SEL_LEN, dh)
        kpos = idx[..., None] * SEL_LEN + jnp.arange(SEL_LEN)
        m_s = (kpos <= tq[:, None, None]).reshape(B, G, 1, Q_BLOCK, n_sel * SEL_LEN)
        s_s = jnp.einsum('bgrqd,bgqnkd->bgrqnk', qblk, kg).reshape(B, G, R, Q_BLOCK, n_sel * SEL_LEN) * scale
        p_s = masked_softmax(s_s, m_s)
        o_s = jnp.einsum('bgrqm,bgqmd->bgrqd', p_s.astype(dt), vg)
        kwb = lax.dynamic_slice_in_dim(kw_pad, s0, WINDOW + Q_BLOCK, axis=2)
        vwb = lax.dynamic_slice_in_dim(vw_pad, s0, WINDOW + Q_BLOCK, axis=2)
        kp = s0 - WINDOW + jnp.arange(WINDOW + Q_BLOCK)
        dpos = tq[:, None] - kp[None, :]
        m_w = (kp[None, :] >= 0) & (dpos >= 0) & (dpos < WINDOW)
        p_w = masked_softmax(jnp.einsum('bgrqd,bgkd->bgrqk', qblk, kwb) * scale, m_w)
        o_w = jnp.einsum('bgrqk,bgkd->bgrqd', p_w.astype(dt), vwb)
        return o_s, o_w

    o_s, o_w = lax.map(block_fn, jnp.arange(S // Q_BLOCK))
    o_s = jnp.moveaxis(o_s, 0, 3).reshape(B, G, R, S, dh)
    o_w = jnp.moveaxis(o_w, 0, 3).reshape(B, G, R, S, dh)

    gl = jax.nn.sigmoid(gate_logits.reshape(B, S, G, R, 3)).transpose(0, 2, 3, 1, 4)
    o = gl[..., 0:1] * o_c + gl[..., 1:2] * o_s + gl[..., 2:3] * o_w
    return o.transpose(0, 3, 1, 2, 4).reshape(B, S, NSA_WIDTH).astype(dt)


def hgrn2_mixer(q, f, i, g, lb, norm_g):
    B, S, _ = q.shape
    dt = q.dtype
    H, dk, dv, C = HGRN_HEADS, HGRN_DK, HGRN_DV, HGRN_CHUNK
    f32 = jnp.float32
    qh = (jax.nn.silu(q.astype(f32)) * dk ** -0.5).reshape(B, S, H, dk)
    lb_h = lb.reshape(H, dk)
    log_f = jnp.logaddexp(jnp.log(lb_h), jnp.log1p(-lb_h) + jax.nn.log_sigmoid(f.astype(f32).reshape(B, S, H, dk)))
    kh = -jnp.expm1(log_f)
    vh = i.astype(f32).reshape(B, S, H, dv)
    nc = S // C

    def to_chunks(t):
        return t.reshape(B, nc, C, H, t.shape[-1]).transpose(1, 0, 3, 2, 4)

    causal = np.tril(np.ones((C, C), dtype=bool))

    def step(state, inp):
        qc, kc, vc, lfc = inp
        b = jnp.cumsum(lfc, axis=2)
        diff = jnp.where(causal[:, :, None], b[:, :, :, None, :] - b[:, :, None, :, :], -jnp.inf)
        a = jnp.sum(qc[:, :, :, None, :] * kc[:, :, None, :, :] * jnp.exp(diff), axis=-1)
        o = jnp.einsum('bhts,bhsv->bhtv', a, vc) + jnp.einsum('bhtd,bhdv->bhtv', qc * jnp.exp(b), state)
        b_last = b[:, :, -1:, :]
        new_state = jnp.exp(b_last[:, :, 0, :])[..., None] * state + jnp.einsum('bhsd,bhsv->bhdv', kc * jnp.exp(b_last - b), vc)
        return new_state, o

    state0 = jnp.zeros((B, H, dk, dv), f32)
    _, o = lax.scan(step, state0, (to_chunks(qh), to_chunks(kh), to_chunks(vh), to_chunks(log_f)))
    o = o.transpose(1, 0, 3, 2, 4).reshape(B, S, H, dv)
    o = o * lax.rsqrt(jnp.mean(jnp.square(o), axis=-1, keepdims=True) + RMS_EPS) * norm_g.astype(f32)
    o = o.reshape(B, S, HGRN_VWIDTH) * jax.nn.silu(g.astype(f32))
    return o.astype(dt)


def setup_inputs(seed: int = 0) -> dict:
    key = jax.random.key(seed)
    ks = jax.random.split(key, 23)
    L, D = DEPTH, D_MODEL

    def nrm(k, shape, scale):
        return scale * jax.random.normal(k, shape, jnp.float32)

    return {
        'x': nrm(ks[0], (BATCH, SEQ, D), 1.0),
        'c': nrm(ks[1], (BATCH, D), 1.0),
        'w_in': nrm(ks[2], (L, D, N_IN), D ** -0.5),
        'b_in': nrm(ks[3], (L, N_IN), 0.02),
        'cmp_pe_k': nrm(ks[4], (L, CMP_LEN, NSA_DH), 0.02),
        'cmp_pe_v': nrm(ks[5], (L, CMP_LEN, NSA_DH), 0.02),
        'cmp_wk1': nrm(ks[6], (L, CMP_LEN * NSA_DH, CMP_HIDDEN), (CMP_LEN * NSA_DH) ** -0.5),
        'cmp_wk2': nrm(ks[7], (L, CMP_HIDDEN, NSA_DH), CMP_HIDDEN ** -0.5),
        'cmp_wv1': nrm(ks[8], (L, CMP_LEN * NSA_DH, CMP_HIDDEN), (CMP_LEN * NSA_DH) ** -0.5),
        'cmp_wv2': nrm(ks[9], (L, CMP_HIDDEN, NSA_DH), CMP_HIDDEN ** -0.5),
        'hgrn_lb_logits': nrm(ks[10], (L, HGRN_WIDTH), 1.0),
        'hgrn_norm_g': 1.0 + nrm(ks[11], (L, HGRN_DV), 0.02),
        'w_branch_a': nrm(ks[12], (L, NSA_WIDTH, D), NSA_WIDTH ** -0.5),
        'w_branch_b': nrm(ks[13], (L, HGRN_VWIDTH, D), HGRN_VWIDTH ** -0.5),
        'w_out': nrm(ks[14], (L, D, D), DEEPNORM_BETA * D ** -0.5),
        'w_ada': nrm(ks[15], (L, D, 6 * D), 0.1 * D ** -0.5),
        'b_ada': nrm(ks[16], (L, 6 * D), 0.02),
        'ln1_g': 1.0 + nrm(ks[17], (L, D), 0.02),
        'ln1_b': nrm(ks[18], (L, D), 0.02),
        'w_mlp1': nrm(ks[19], (L, D, MLP_HIDDEN), D ** -0.5),
        'w_mlp2': nrm(ks[20], (L, MLP_HIDDEN, D), DEEPNORM_BETA * MLP_HIDDEN ** -0.5),
        'ln2_g': 1.0 + nrm(ks[21], (L, D), 0.02),
        'ln2_b': nrm(ks[22], (L, D), 0.02),
    }


def reference(x, c, w_in, b_in, cmp_pe_k, cmp_pe_v, cmp_wk1, cmp_wk2, cmp_wv1, cmp_wv2, hgrn_lb_logits, hgrn_norm_g, w_branch_a, w_branch_b, w_out, w_ada, b_ada, ln1_g, ln1_b, w_mlp1, w_mlp2, ln2_g, ln2_b):
    lb_all = jnp.cumsum(jax.nn.softmax(hgrn_lb_logits.astype(jnp.float32), axis=0), axis=0)
    lb_all = lb_all - lb_all[0:1]
    cond = jax.nn.silu(c)
    for l in range(DEPTH):
        mod = cond @ w_ada[l] + b_ada[l]
        sh1, sc1, gt1, sh2, sc2, gt2 = [m[:, None, :] for m in jnp.split(mod, 6, axis=-1)]
        u = x * (1.0 + sc1) + sh1
        h = u @ w_in[l] + b_in[l]
        q_a, k_c, v_c, k_s, v_s, k_w, v_w, g_a, q_b, f_b, i_b, g_b, gm_a, gm_b = jnp.split(h, IN_OFFSETS, axis=-1)
        y_a = nsa_mixer(q_a, k_c, v_c, k_s, v_s, k_w, v_w, g_a, cmp_pe_k[l], cmp_pe_v[l], cmp_wk1[l], cmp_wk2[l], cmp_wv1[l], cmp_wv2[l])
        y_b = hgrn2_mixer(q_b, f_b, i_b, g_b, lb_all[l], hgrn_norm_g[l])
        merged = jax.nn.sigmoid(gm_a) * (y_a @ w_branch_a[l]) + jax.nn.sigmoid(gm_b) * (y_b @ w_branch_b[l])
        y = merged @ w_out[l]
        x = layer_norm(DEEPNORM_ALPHA * x + (1.0 + gt1) * y, ln1_g[l], ln1_b[l])
        u = x * (1.0 + sc2) + sh2
        y = jnp.square(jax.nn.relu(u @ w_mlp1[l])) @ w_mlp2[l]
        x = layer_norm(DEEPNORM_ALPHA * x + (1.0 + gt2) * y, ln2_g[l], ln2_b[l])
    return x
```

```cpp
#include <hip/hip_runtime.h>
#include <hip/hip_cooperative_groups.h>
#include <cstdio>
#include <cstdint>
namespace cg = cooperative_groups;

#define LAS __attribute__((address_space(3)))
typedef unsigned short bf16_t;
typedef short bf16x8 __attribute__((ext_vector_type(8)));
typedef short s16x4 __attribute__((ext_vector_type(4)));
typedef float f32x4 __attribute__((ext_vector_type(4)));
typedef float f32x2 __attribute__((ext_vector_type(2)));
typedef float f32x16 __attribute__((ext_vector_type(16)));
typedef unsigned u32x4 __attribute__((ext_vector_type(4)));
typedef unsigned u32x2 __attribute__((ext_vector_type(2)));
typedef LAS unsigned char* lptr;

constexpr int DM = 1024, NB = 32, SEQ = 2048, NT = NB * SEQ, FF = 4096, NIN = 5400, NINP = 5632, HP = 5400;
constexpr int C_QA = 0, C_KC = 512, C_KS = 640, C_KW = 768, C_VC = 896, C_VS = 1024, C_VW = 1152, C_GATE = 1280, C_QB = 1304, C_FB = 1816,
              C_IB = 2328, C_GB = 2840, C_GMA = 3352, C_GMB = 4376;
constexpr float QSCALE = 0.125f * 1.4426950408889634f;
constexpr float LN_EPS = 1e-5f, RMS_EPS = 1e-6f, DN_ALPHA = 1.4142135623730951f;
constexpr size_t MiB = 1u << 20;
constexpr size_t WS_MOD = 0;
constexpr size_t WS_COS = 2 * MiB;
constexpr size_t WS_SIN = 2 * MiB + 512 * 1024;
constexpr size_t WS_BIAS = 3 * MiB;
constexpr size_t WS_C1 = 3 * MiB + 256 * 1024;
constexpr size_t WS_KCC = 4 * MiB;
constexpr size_t WS_WIN = 8 * MiB;
constexpr size_t WS_WBA = 30 * MiB;
constexpr size_t WS_WBB = 32 * MiB;
constexpr size_t WS_WOUT = 34 * MiB;
constexpr size_t WS_W1 = 38 * MiB;
constexpr size_t WS_W2 = 54 * MiB;
constexpr size_t WS_CW1 = 70 * MiB;
constexpr size_t WS_CW2 = 72 * MiB;
constexpr size_t WS_ACT = 74 * MiB;
constexpr size_t WS_H = 202 * MiB;
constexpr size_t WS_Y = 714 * MiB;
constexpr size_t WS_END = 970 * MiB;
constexpr int LDS_BYTES = 147456;

struct Params {
    const float* in[23];
    float* out;
    unsigned char* ws;
    int ph_lo, ph_hi;
};

__device__ __forceinline__ unsigned f2bf(float f) { unsigned u = __builtin_bit_cast(unsigned, f); return (u + 0x7fffu + ((u >> 16) & 1u)) >> 16; }
__device__ __forceinline__ unsigned pk2(float lo, float hi) { return f2bf(lo) | (f2bf(hi) << 16); }
__device__ __forceinline__ float bflo(unsigned w) { return __builtin_bit_cast(float, w << 16); }
__device__ __forceinline__ float bfhi(unsigned w) { return __builtin_bit_cast(float, w & 0xffff0000u); }
__device__ __forceinline__ float bf2f(bf16_t b) { return __builtin_bit_cast(float, (unsigned)b << 16); }
__device__ __forceinline__ float fexp(float x) { return __builtin_amdgcn_exp2f(x * 1.4426950408889634f); }
__device__ __forceinline__ float sigmoidf_(float x) { return 1.0f / (1.0f + fexp(-x)); }
__device__ __forceinline__ int crow(int r, int hi) { return (r & 3) + 8 * (r >> 2) + 4 * hi; }
__device__ __forceinline__ int dmap(int c) { return (c >> 1) + 32 * (c & 1); }
__device__ __forceinline__ f32x16 mfma32(bf16x8 a, bf16x8 b, f32x16 c) { return __builtin_amdgcn_mfma_f32_32x32x16_bf16(a, b, c, 0, 0, 0); }
__device__ __forceinline__ f32x16 zero16() { return (f32x16){0.f,0.f,0.f,0.f,0.f,0.f,0.f,0.f,0.f,0.f,0.f,0.f,0.f,0.f,0.f,0.f}; }
__device__ __forceinline__ float wave_sum(float v) {
#pragma unroll
    for (int o = 1; o < 64; o <<= 1) v += __shfl_xor(v, o);
    return v;
}

namespace pg8 {
constexpr int BM = 256, BK = 64, HALF = 128, HTB = HALF * BK * 2, STAGE_BYTES = 8 * HTB, NXCD = 8, WGM = 8;
__host__ __device__ __forceinline__ int lds_byte(int r, int c) { const int st = (r >> 4) * 2 + (c >> 5), rr = r & 15, cc = c & 31, ob = rr * 64 + cc * 2; return st * 1024 + (ob ^ (((ob >> 9) & 1) << 5)); }
__host__ __device__ __forceinline__ void stage_rc(int b, int& R, int& C) { const int st = b / 1024, sb = b % 1024, swz = sb ^ (((sb >> 9) & 1) << 5); R = (st >> 1) * 16 + swz / 64; C = (st & 1) * 32 + (swz % 64) / 2; }
__host__ __device__ __forceinline__ int perm32(int rho) { const int n = rho >> 4, i = rho & 15; return 8 * (i >> 2) + 4 * n + (i & 3); }
struct Unit { int pm, pn; };
struct Gemm { const bf16_t* A; const bf16_t* Bt; int M, N, K, lda, ldb; };
struct StaticOrder {
    int nM, nN, nwg, G, c;
    __host__ __device__ void init(int M, int N, int G_, int c_) { nM = M / BM; nN = N / BM; nwg = nM * nN; G = G_; c = c_; }
    __host__ __device__ bool next(int i, Unit& u) const {
        const long L = (long)i * G + c; if (L >= nwg) return false;
        int wgid = (int)L; { const int q = nwg / NXCD, r = nwg % NXCD, xcd = wgid % NXCD, off = wgid / NXCD; wgid = (xcd < r ? xcd * (q + 1) : r * (q + 1) + (xcd - r) * q) + off; }
        const int nig = WGM * nN, gid = wgid / nig, fm = gid * WGM, gsz = (nM - fm) < WGM ? (nM - fm) : WGM;
        u.pm = fm + ((wgid % nig) % gsz); u.pn = (wgid % nig) / gsz; return true;
    }
};
template <class Epi>
__device__ __forceinline__ void gemm_phase(LAS unsigned char* lds, const Gemm g, const StaticOrder& S, const Epi& E) {
    int tid_ = threadIdx.x; asm volatile("" : "+v"(tid_)); const int tid = tid_, wid = __builtin_amdgcn_readfirstlane(tid >> 6), lane = tid & 63, wr = wid >> 2, wc = wid & 3, fr = lane & 15, fq = lane >> 4;
    const int K = g.K, nt = K / BK;
    unsigned voffA[2], voffB[2];
#pragma unroll
    for (int i = 0; i < 2; ++i) { int R, C; stage_rc(tid * 16 + i * 8192, R, C); const int Rb = (R & ~31) + perm32(R & 31);
        voffA[i] = (unsigned)(R * g.lda + C) * 2u; voffB[i] = (unsigned)(Rb * g.ldb + C) * 2u; }
    const size_t kstep = (size_t)(BK * 2);
    const size_t hstepA = (size_t)HALF * g.lda * 2, hstepB = (size_t)HALF * g.ldb * 2;
    const size_t tstepA = 2 * hstepA, tstepB = 2 * hstepB;
    const unsigned ldsw = (unsigned)wid * 1024u;
    const int aoff = lds_byte(wr * 64 + fr, fq * 8), boff = lds_byte(wc * 32 + fr, fq * 8);
#define PG8_SA(b, h) (((b) * 2 + (h)) * HTB)
#define PG8_SB(b, h) ((4 + (b) * 2 + (h)) * HTB)
#define PG8_STAGE(bufoff, gbase, voff) do { _Pragma("unroll") for (int _i = 0; _i < 2; ++_i) \
        __builtin_amdgcn_global_load_lds((const unsigned*)((const char*)(gbase) + (voff)[_i]), (LAS unsigned*)(lds + (bufoff) + ldsw + _i * 8192), 16, 0, 0); } while (0)
#define PG8_LDA(dst, b, h) do { _Pragma("unroll") for (int m = 0; m < 4; ++m) _Pragma("unroll") for (int k = 0; k < 2; ++k) dst[m][k] = *(const LAS bf16x8*)(lds + PG8_SA(b, h) + aoff + m * 2048 + k * 1024); } while (0)
#define PG8_LDB(dst, b, h) do { _Pragma("unroll") for (int n = 0; n < 2; ++n) _Pragma("unroll") for (int k = 0; k < 2; ++k) dst[n][k] = *(const LAS bf16x8*)(lds + PG8_SB(b, h) + boff + n * 2048 + k * 1024); } while (0)
#define PG8_MMA(ai, bj, At, Bt) do { __builtin_amdgcn_s_setprio(1); _Pragma("unroll") for (int m = 0; m < 4; ++m) _Pragma("unroll") for (int n = 0; n < 2; ++n) _Pragma("unroll") for (int k = 0; k < 2; ++k) \
        acc[ai][bj][m][n] = __builtin_amdgcn_mfma_f32_16x16x32_bf16(Bt[n][k], At[m][k], acc[ai][bj][m][n], 0, 0, 0); __builtin_amdgcn_s_setprio(0); } while (0)
#define PG8_WAIT_V(n) asm volatile("s_waitcnt vmcnt(" #n ")" ::: "memory")
#define PG8_WAIT_L(n) asm volatile("s_waitcnt lgkmcnt(" #n ")" ::: "memory")
#define PG8_BAR __builtin_amdgcn_s_barrier()
#define PG8_SCHED __builtin_amdgcn_sched_barrier(0)
    Unit cur, nxt; int ui = 0;
    if (!S.next(0, cur)) return;
    f32x4 acc[2][2][4][2];
#pragma unroll
    for (int a = 0; a < 2; ++a)
#pragma unroll
        for (int b = 0; b < 2; ++b)
#pragma unroll
            for (int m = 0; m < 4; ++m)
#pragma unroll
                for (int n = 0; n < 2; ++n) acc[a][b][m][n] = (f32x4){0.f, 0.f, 0.f, 0.f};
    bf16x8 At[4][2], B0[2][2], B1[2][2];
    const char* cA = (const char*)g.A + (size_t)cur.pm * tstepA; const char* cB = (const char*)g.Bt + (size_t)cur.pn * tstepB;
    PG8_STAGE(PG8_SB(0, 0), cB, voffB); PG8_STAGE(PG8_SB(0, 1), cB + hstepB, voffB); PG8_STAGE(PG8_SA(0, 0), cA, voffA); PG8_STAGE(PG8_SA(0, 1), cA + hstepA, voffA);
    if (wr == 1) PG8_BAR;
    PG8_WAIT_V(2); PG8_BAR;
    PG8_STAGE(PG8_SB(1, 0), cB + kstep, voffB); PG8_STAGE(PG8_SA(1, 0), cA + kstep, voffA); PG8_STAGE(PG8_SB(1, 1), cB + hstepB + kstep, voffB);
    PG8_WAIT_V(6); PG8_BAR;
    for (;;) {
        const bool has_next = S.next(ui + 1, nxt);
        const char* nA = has_next ? (const char*)g.A + (size_t)nxt.pm * tstepA : cA; const char* nB = has_next ? (const char*)g.Bt + (size_t)nxt.pn * tstepB : cB;
        for (int t = 0; t < nt; t += 2) {
            const bool last = (t == nt - 2);
            const char* a1 = cA + (size_t)(t + 1) * kstep;
            const char* a2 = last ? nA : cA + (size_t)(t + 2) * kstep; const char* b2 = last ? nB : cB + (size_t)(t + 2) * kstep;
            const char* a3 = a2 + kstep; const char* b3 = b2 + kstep;
            PG8_LDB(B0, 0, 0); PG8_LDB(B1, 0, 1); PG8_SCHED; PG8_LDA(At, 0, 0); PG8_STAGE(PG8_SA(1, 1), a1 + hstepA, voffA);
            PG8_WAIT_V(8); PG8_WAIT_L(0); PG8_BAR; PG8_MMA(0, 0, At, B0); PG8_MMA(0, 1, At, B1); PG8_BAR; PG8_SCHED;
            PG8_LDA(At, 0, 1); PG8_STAGE(PG8_SB(0, 0), b2, voffB); PG8_STAGE(PG8_SB(0, 1), b2 + hstepB, voffB); PG8_STAGE(PG8_SA(0, 0), a2, voffA);
            PG8_WAIT_V(8); PG8_WAIT_L(0); PG8_BAR; PG8_MMA(1, 0, At, B0); PG8_MMA(1, 1, At, B1); PG8_BAR; PG8_SCHED;
            PG8_LDB(B0, 1, 0); PG8_LDB(B1, 1, 1); PG8_SCHED; PG8_LDA(At, 1, 0); PG8_STAGE(PG8_SA(0, 1), a2 + hstepA, voffA);
            PG8_WAIT_V(8); PG8_WAIT_L(0); PG8_BAR; PG8_MMA(0, 0, At, B0); PG8_MMA(0, 1, At, B1); PG8_BAR; PG8_SCHED;
            PG8_LDA(At, 1, 1); PG8_STAGE(PG8_SB(1, 0), b3, voffB); PG8_STAGE(PG8_SB(1, 1), b3 + hstepB, voffB); PG8_STAGE(PG8_SA(1, 0), a3, voffA);
            PG8_WAIT_V(8); PG8_WAIT_L(0); PG8_BAR; PG8_MMA(1, 0, At, B0); PG8_MMA(1, 1, At, B1); PG8_BAR; PG8_SCHED;
        }
        if (wr == 0) PG8_BAR;
        E(acc, cur, wr, wc, fr, fq);
        if (!has_next) break;
#pragma unroll
        for (int a = 0; a < 2; ++a)
#pragma unroll
            for (int b = 0; b < 2; ++b)
#pragma unroll
                for (int m = 0; m < 4; ++m)
#pragma unroll
                    for (int n = 0; n < 2; ++n) acc[a][b][m][n] = (f32x4){0.f, 0.f, 0.f, 0.f};
        cur = nxt; cA = nA; cB = nB; ++ui;
        if (wr == 1) PG8_BAR;
    }
    PG8_WAIT_V(0);
    PG8_BAR;
#undef PG8_SA
#undef PG8_SB
#undef PG8_STAGE
#undef PG8_LDA
#undef PG8_LDB
#undef PG8_MMA
#undef PG8_WAIT_V
#undef PG8_WAIT_L
#undef PG8_BAR
#undef PG8_SCHED
}
}

typedef f32x4 AccT[2][2][4][2];
#define EPI_LOOP_BEGIN \
    const int row0 = u.pm * 256 + wr * 64 + fr, colb = u.pn * 256 + wc * 32 + 8 * fq; \
    _Pragma("unroll") for (int bj = 0; bj < 2; ++bj) { const int col = colb + bj * 128;
#define EPI_ROWS_BEGIN \
    _Pragma("unroll") for (int ai = 0; ai < 2; ++ai) { asm volatile("" ::: "memory"); _Pragma("unroll") for (int m = 0; m < 4; ++m) { const int row = row0 + ai * 128 + m * 16; \
        f32x4 v0 = acc[ai][bj][m][0], v1 = acc[ai][bj][m][1];
#define EPI_END } } }
__device__ __forceinline__ u32x4 pack8(f32x4 v0, f32x4 v1) { u32x4 w; w.x = pk2(v0[0], v0[1]); w.y = pk2(v0[2], v0[3]); w.z = pk2(v1[0], v1[1]); w.w = pk2(v1[2], v1[3]); return w; }

struct EpiInProj {
    bf16_t* H; const float* bias; const float* cosT; const float* sinT;
    __device__ __forceinline__ void operator()(const AccT& acc, const pg8::Unit& u, int wr, int wc, int fr, int fq) const {
        EPI_LOOP_BEGIN
            if (col < NIN) {
                const f32x4 b0 = *(const f32x4*)(bias + col), b1 = *(const f32x4*)(bias + col + 4);
                const bool rope = col < C_VC; const int i0 = (col & 63) >> 1; const float qs = col < C_KC ? QSCALE : 1.0f;
                EPI_ROWS_BEGIN
                    v0 = v0 + b0; v1 = v1 + b1;
                    if (rope) {
                        const int pos = row & (SEQ - 1);
                        const f32x4 c4 = *(const f32x4*)(cosT + pos * 32 + i0), s4 = *(const f32x4*)(sinT + pos * 32 + i0);
                        f32x4 o0, o1;
                        o0[0] = v0[0] * c4[0] - v0[1] * s4[0]; o0[1] = v0[1] * c4[0] + v0[0] * s4[0];
                        o0[2] = v0[2] * c4[1] - v0[3] * s4[1]; o0[3] = v0[3] * c4[1] + v0[2] * s4[1];
                        o1[0] = v1[0] * c4[2] - v1[1] * s4[2]; o1[1] = v1[1] * c4[2] + v1[0] * s4[2];
                        o1[2] = v1[2] * c4[3] - v1[3] * s4[3]; o1[3] = v1[3] * c4[3] + v1[2] * s4[3];
                        v0 = o0 * qs; v1 = o1 * qs;
                    }
                    *(u32x4*)(H + (size_t)row * HP + col) = pack8(v0, v1);
                } }
            }
        }
    }
};
__device__ __forceinline__ void sig8(u32x4 g, f32x4& s0, f32x4& s1) {
    s0[0] = sigmoidf_(bflo(g.x)); s0[1] = sigmoidf_(bfhi(g.x)); s0[2] = sigmoidf_(bflo(g.y)); s0[3] = sigmoidf_(bfhi(g.y));
    s1[0] = sigmoidf_(bflo(g.z)); s1[1] = sigmoidf_(bfhi(g.z)); s1[2] = sigmoidf_(bflo(g.w)); s1[3] = sigmoidf_(bfhi(g.w));
}
template <int SECOND> struct EpiBranch {
    bf16_t* ACT; const bf16_t* Hg;
    __device__ __forceinline__ void operator()(const AccT& acc, const pg8::Unit& u, int wr, int wc, int fr, int fq) const {
        EPI_LOOP_BEGIN
            EPI_ROWS_BEGIN
                const u32x4 g = *(const u32x4*)(Hg + (size_t)row * HP + col);
                f32x4 s0, s1; sig8(g, s0, s1);
                v0 = v0 * s0; v1 = v1 * s1;
                bf16_t* dst = ACT + (size_t)row * DM + col;
                if (SECOND) { const u32x4 p = *(const u32x4*)dst;
                    v0[0] += bflo(p.x); v0[1] += bfhi(p.x); v0[2] += bflo(p.y); v0[3] += bfhi(p.y);
                    v1[0] += bflo(p.z); v1[1] += bfhi(p.z); v1[2] += bflo(p.w); v1[3] += bfhi(p.w); }
                *(u32x4*)dst = pack8(v0, v1);
        EPI_END
    }
};
struct EpiF32 {
    float* Y;
    __device__ __forceinline__ void operator()(const AccT& acc, const pg8::Unit& u, int wr, int wc, int fr, int fq) const {
        EPI_LOOP_BEGIN
            EPI_ROWS_BEGIN
                float* dst = Y + (size_t)row * DM + col;
                *(f32x4*)dst = v0; *(f32x4*)(dst + 4) = v1;
        EPI_END
    }
};
struct EpiRelu2 {
    bf16_t* Hd;
    __device__ __forceinline__ void operator()(const AccT& acc, const pg8::Unit& u, int wr, int wc, int fr, int fq) const {
        EPI_LOOP_BEGIN
            EPI_ROWS_BEGIN
#pragma unroll
                for (int e = 0; e < 4; ++e) { const float a = fmaxf(v0[e], 0.f), b = fmaxf(v1[e], 0.f); v0[e] = a * a; v1[e] = b * b; }
                *(u32x4*)(Hd + (size_t)row * FF + col) = pack8(v0, v1);
        EPI_END
    }
};

__device__ __forceinline__ int inproj_src(int j) {
    if (j < 512) return (j & ~63) | dmap(j & 63);
    if (j < 896) { const int seg = (j - 512) >> 7, w = (j - 512) & 127; const int base = seg == 0 ? 512 : (seg == 1 ? 768 : 1024); return base + (w & 64) + dmap(w & 63); }
    if (j < 1280) { const int seg = (j - 896) >> 7, w = (j - 896) & 127; const int base = seg == 0 ? 640 : (seg == 1 ? 896 : 1152); return base + w; }
    if (j < NIN) return j;
    return -1;
}
template <int COLMODE, int ROWMODE>
__device__ __forceinline__ void transpose_item(const float* W, int N, bf16_t* WT, int Kd, LAS float* scr, int kb, int nb, int lane) {
    const int k0 = 64 * kb, n0 = 32 * nb; const int j = n0 + (lane & 31);
    int sc = j; if (COLMODE == 1) sc = inproj_src(j); if (COLMODE == 2) sc = (j & ~63) | dmap(j & 63);
#pragma unroll 8
    for (int i = 0; i < 32; ++i) { const int kk = 2 * i + (lane >> 5); int sr = k0 + kk; if (ROWMODE == 1) sr = (sr & ~63) | dmap(sr & 63);
        scr[kk * 33 + (lane & 31)] = sc >= 0 ? W[(size_t)sr * N + sc] : 0.f; }
    asm volatile("s_waitcnt lgkmcnt(0)" ::: "memory");
    const int c = lane & 7;
#pragma unroll
    for (int jj = 0; jj < 4; ++jj) { const int n = (lane >> 3) + 8 * jj; const LAS float* s = scr + (8 * c) * 33 + n;
        u32x4 o; o.x = pk2(s[0 * 33], s[1 * 33]); o.y = pk2(s[2 * 33], s[3 * 33]); o.z = pk2(s[4 * 33], s[5 * 33]); o.w = pk2(s[6 * 33], s[7 * 33]);
        *(u32x4*)(WT + (size_t)(n0 + n) * Kd + k0 + 8 * c) = o; }
    asm volatile("s_waitcnt lgkmcnt(0)" ::: "memory");
}

__device__ __forceinline__ void phase_prologue(const Params& p, lptr L) {
    int tid_ = threadIdx.x; asm volatile("" : "+v"(tid_)); const int tid = tid_, lane = tid & 63, wave = __builtin_amdgcn_readfirstlane(tid >> 6);
    const int G = gridDim.x;
    unsigned char* ws = p.ws;
    for (int u = blockIdx.x; u < 196; u += G) {
        if (u < 192) {
            const int l = u / 96, cc = u % 96;
            LAS float* COND = (LAS float*)L;
            for (int i = 0; i < 64; ++i) { const int e = tid + 512 * i, b = e >> 10, k = e & 1023; const float v = p.in[1][b * 1024 + k]; COND[k * 32 + b] = v * sigmoidf_(v); }
            __syncthreads();
            const float* wp = p.in[15] + (size_t)l * 1024 * 6144 + cc * 64 + lane;
            float acc[32];
#pragma unroll
            for (int b = 0; b < 32; ++b) acc[b] = 0.f;
            for (int kk = 0; kk < 128; ++kk) { const int k = wave * 128 + kk; const float wv = wp[(size_t)k * 6144];
#pragma unroll
                for (int b4 = 0; b4 < 8; ++b4) { const f32x4 c4 = *(const LAS f32x4*)(COND + k * 32 + 4 * b4);
                    acc[4 * b4 + 0] += c4[0] * wv; acc[4 * b4 + 1] += c4[1] * wv; acc[4 * b4 + 2] += c4[2] * wv; acc[4 * b4 + 3] += c4[3] * wv; } }
            __syncthreads();
            LAS float* RED = (LAS float*)L;
#pragma unroll
            for (int b = 0; b < 32; ++b) RED[(wave * 32 + b) * 64 + lane] = acc[b];
            __syncthreads();
            float* mod = (float*)(ws + WS_MOD) + (size_t)l * 32 * 6144;
            for (int i = 0; i < 4; ++i) { const int e = tid + 512 * i, b = e >> 6, cl = e & 63; float s = 0.f;
#pragma unroll
                for (int w = 0; w < 8; ++w) s += RED[(w * 32 + b) * 64 + cl];
                mod[(size_t)b * 6144 + cc * 64 + cl] = s + p.in[16][l * 6144 + cc * 64 + cl]; }
            __syncthreads();
        } else {
            const int l = (u - 192) >> 1, kv = (u - 192) & 1;
            const float* pe = p.in[kv ? 5 : 4] + l * 2048; const float* w1 = p.in[kv ? 8 : 6] + (size_t)l * 2048 * 128;
            const int ks = tid >> 7, n = tid & 127; float s = 0.f;
            for (int k = ks * 512; k < ks * 512 + 512; ++k) s += pe[k] * w1[(size_t)k * 128 + n];
            LAS float* RED = (LAS float*)L; RED[ks * 128 + n] = s;
            __syncthreads();
            if (tid < 128) ((float*)(ws + WS_C1))[(l * 2 + kv) * 128 + tid] = RED[tid] + RED[128 + tid] + RED[256 + tid] + RED[384 + tid];
            __syncthreads();
        }
    }
    const int gt = blockIdx.x * 512 + tid, NGT = G * 512;
    for (int e = gt; e < SEQ * 32; e += NGT) { const int pos = e >> 5, i = e & 31;
        const float inv = 1.0f / powf(10000.0f, (float)(2 * i) / 64.0f); const float ang = (float)pos * inv;
        const double rev = (double)ang * 0.15915494309189535; const float fr = (float)(rev - floor(rev));
        ((float*)(ws + WS_COS))[e] = __builtin_amdgcn_cosf(fr); ((float*)(ws + WS_SIN))[e] = __builtin_amdgcn_sinf(fr); }
    for (int e = gt; e < 2 * NINP; e += NGT) { const int l = e / NINP, j = e % NINP; const int s = inproj_src(j); ((float*)(ws + WS_BIAS))[e] = s >= 0 ? p.in[3][l * NIN + s] : 0.f; }
    LAS float* scr = (LAS float*)(L + wave * 8448);
    const int gw = blockIdx.x * 8 + wave, NGW = G * 8;
    for (int it = gw; it < 16400; it += NGW) {
        int r = it;
        if (r < 5632) { const int l = r / 2816, q = r % 2816; transpose_item<1, 0>(p.in[2] + (size_t)l * 1024 * NIN, NIN, (bf16_t*)(ws + WS_WIN) + (size_t)l * NINP * 1024, 1024, scr, q / 176, q % 176, lane); continue; } r -= 5632;
        if (r < 512) { const int l = r / 256, q = r % 256; transpose_item<0, 0>(p.in[12] + (size_t)l * 512 * 1024, 1024, (bf16_t*)(ws + WS_WBA) + (size_t)l * 1024 * 512, 512, scr, q / 32, q % 32, lane); continue; } r -= 512;
        if (r < 512) { const int l = r / 256, q = r % 256; transpose_item<0, 0>(p.in[13] + (size_t)l * 512 * 1024, 1024, (bf16_t*)(ws + WS_WBB) + (size_t)l * 1024 * 512, 512, scr, q / 32, q % 32, lane); continue; } r -= 512;
        if (r < 1024) { const int l = r / 512, q = r % 512; transpose_item<0, 0>(p.in[14] + (size_t)l * 1024 * 1024, 1024, (bf16_t*)(ws + WS_WOUT) + (size_t)l * 1024 * 1024, 1024, scr, q / 32, q % 32, lane); continue; } r -= 1024;
        if (r < 4096) { const int l = r / 2048, q = r % 2048; transpose_item<0, 0>(p.in[19] + (size_t)l * 1024 * 4096, 4096, (bf16_t*)(ws + WS_W1) + (size_t)l * 4096 * 1024, 1024, scr, q / 128, q % 128, lane); continue; } r -= 4096;
        if (r < 4096) { const int l = r / 2048, q = r % 2048; transpose_item<0, 0>(p.in[20] + (size_t)l * 4096 * 1024, 1024, (bf16_t*)(ws + WS_W2) + (size_t)l * 1024 * 4096, 4096, scr, q / 32, q % 32, lane); continue; } r -= 4096;
        if (r < 256) { const int l = r / 128, q = r % 128; transpose_item<0, 1>(p.in[6] + (size_t)l * 2048 * 128, 128, (bf16_t*)(ws + WS_CW1) + (size_t)(l * 2 + 0) * 128 * 2048, 2048, scr, q / 4, q % 4, lane); continue; } r -= 256;
        if (r < 256) { const int l = r / 128, q = r % 128; transpose_item<0, 0>(p.in[8] + (size_t)l * 2048 * 128, 128, (bf16_t*)(ws + WS_CW1) + (size_t)(l * 2 + 1) * 128 * 2048, 2048, scr, q / 4, q % 4, lane); continue; } r -= 256;
        if (r < 8) { const int l = r / 4, q = r % 4; transpose_item<2, 0>(p.in[7] + (size_t)l * 128 * 64, 64, (bf16_t*)(ws + WS_CW2) + (size_t)(l * 2 + 0) * 64 * 128, 128, scr, q / 2, q % 2, lane); continue; } r -= 8;
        { const int l = r / 4, q = r % 4; transpose_item<0, 0>(p.in[9] + (size_t)l * 128 * 64, 64, (bf16_t*)(ws + WS_CW2) + (size_t)(l * 2 + 1) * 64 * 128, 128, scr, q / 2, q % 2, lane); }
    }
}

__device__ __forceinline__ void phase_modulate(const Params& p, const float* x, int l) {
    int tid_ = threadIdx.x; asm volatile("" : "+v"(tid_)); const int tid = tid_, lane = tid & 63, wave = tid >> 6; const int gw = blockIdx.x * 8 + wave, NGW = gridDim.x * 8;
    const float* mod = (const float*)(p.ws + WS_MOD) + (size_t)l * 32 * 6144; bf16_t* ACT = (bf16_t*)(p.ws + WS_ACT);
    for (int row = gw; row < NT; row += NGW) { const int b = row >> 11; const float* sh = mod + (size_t)b * 6144; const float* sc = sh + 1024;
#pragma unroll
        for (int j = 0; j < 4; ++j) { const int c = 4 * lane + 256 * j; const f32x4 v = *(const f32x4*)(x + (size_t)row * DM + c), a = *(const f32x4*)(sc + c), d = *(const f32x4*)(sh + c);
            const f32x4 o = v * (a + 1.0f) + d; u32x2 w; w.x = pk2(o[0], o[1]); w.y = pk2(o[2], o[3]); *(u32x2*)(ACT + (size_t)row * DM + c) = w; } }
}
__device__ __forceinline__ void phase_ln(const Params& p, const float* xin, const float* Y, float* xout, const float* gtv  ,
                                         const float* gam, const float* bet, const float* nsh  , const float* nsc) {
    int tid_ = threadIdx.x; asm volatile("" : "+v"(tid_)); const int tid = tid_, lane = tid & 63, wave = tid >> 6; const int gw = blockIdx.x * 8 + wave, NGW = gridDim.x * 8;
    bf16_t* ACT = (bf16_t*)(p.ws + WS_ACT);
    for (int row = gw; row < NT; row += NGW) { const int b = row >> 11; f32x4 v[4]; float s = 0.f;
#pragma unroll
        for (int j = 0; j < 4; ++j) { const int c = 4 * lane + 256 * j; const f32x4 xv = *(const f32x4*)(xin + (size_t)row * DM + c), yv = *(const f32x4*)(Y + (size_t)row * DM + c), gv = *(const f32x4*)(gtv + (size_t)b * 6144 + c);
            v[j] = xv * DN_ALPHA + (gv + 1.0f) * yv; s += (v[j][0] + v[j][1]) + (v[j][2] + v[j][3]); }
        const float mean = wave_sum(s) * (1.f / DM); float s2 = 0.f;
#pragma unroll
        for (int j = 0; j < 4; ++j) { v[j] = v[j] - mean; s2 += (v[j][0] * v[j][0] + v[j][1] * v[j][1]) + (v[j][2] * v[j][2] + v[j][3] * v[j][3]); }
        const float rstd = 1.0f / sqrtf(wave_sum(s2) * (1.f / DM) + LN_EPS);
#pragma unroll
        for (int j = 0; j < 4; ++j) { const int c = 4 * lane + 256 * j; const f32x4 o = v[j] * rstd * *(const f32x4*)(gam + c) + *(const f32x4*)(bet + c);
            *(f32x4*)(xout + (size_t)row * DM + c) = o;
            if (nsh) { const f32x4 a = *(const f32x4*)(nsc + (size_t)b * 6144 + c), d = *(const f32x4*)(nsh + (size_t)b * 6144 + c); const f32x4 q = o * (a + 1.0f) + d;
                u32x2 w; w.x = pk2(q[0], q[1]); w.y = pk2(q[2], q[3]); *(u32x2*)(ACT + (size_t)row * DM + c) = w; } } }
}

__device__ __forceinline__ void compress_unit(const Params& p, int l, int unit, lptr L) {
    int tid_ = threadIdx.x; asm volatile("" : "+v"(tid_)); const int tid = tid_, lane = tid & 63, w = __builtin_amdgcn_readfirstlane(tid >> 6), i = lane & 31, hi = lane >> 5;
    const int bg = unit >> 1, kv = unit & 1, b = bg >> 1, g = bg & 1;
    const bf16_t* H = (const bf16_t*)(p.ws + WS_H);
    const bf16_t* src = H + (size_t)b * SEQ * HP + (kv ? C_VC : C_KC) + g * 64;
    const bf16_t* W1t = (const bf16_t*)(p.ws + WS_CW1) + (size_t)(l * 2 + kv) * 128 * 2048;
    const bf16_t* W2t = (const bf16_t*)(p.ws + WS_CW2) + (size_t)(l * 2 + kv) * 64 * 128;
    const float* c1 = (const float*)(p.ws + WS_C1) + (l * 2 + kv) * 128;
    const int mt = w & 3, nh = w >> 2;
    int nrow = 32 * mt + i; if (nrow > 126) nrow = 126;
    const bf16_t* arow = src + (size_t)(16 * nrow) * HP + 8 * hi;
    const bf16_t* b0row = W1t + (size_t)(64 * nh + i) * 2048 + 8 * hi;
    const bf16_t* b1row = b0row + 32 * 2048;
    f32x16 acc0 = zero16(), acc1 = zero16();
#pragma unroll 4
    for (int ks = 0; ks < 128; ++ks) { const int pp = ks >> 2, dc = ks & 3;
        const bf16x8 a = *(const bf16x8*)(arow + (size_t)pp * HP + dc * 16);
        const bf16x8 b0 = *(const bf16x8*)(b0row + ks * 16), b1 = *(const bf16x8*)(b1row + ks * 16);
        acc0 = mfma32(a, b0, acc0); acc1 = mfma32(a, b1, acc1); }
    LAS bf16_t* Hh = (LAS bf16_t*)L;
    { const float cb0 = c1[64 * nh + i], cb1 = c1[64 * nh + 32 + i];
#pragma unroll
      for (int r = 0; r < 16; ++r) { const int row = 32 * mt + crow(r, hi); float x0 = acc0[r] + cb0, x1 = acc1[r] + cb1; x0 = x0 * sigmoidf_(x0); x1 = x1 * sigmoidf_(x1);
          Hh[row * 136 + 64 * nh + i] = (bf16_t)f2bf(x0); Hh[row * 136 + 64 * nh + 32 + i] = (bf16_t)f2bf(x1); } }
    __syncthreads();
    { const int mt2 = w & 3, nt2 = w >> 2; f32x16 acc = zero16();
#pragma unroll
      for (int ks = 0; ks < 8; ++ks) { const bf16x8 a = *(const LAS bf16x8*)(Hh + (32 * mt2 + i) * 136 + 16 * ks + 8 * hi);
          const bf16x8 bb = *(const bf16x8*)(W2t + (size_t)(32 * nt2 + i) * 128 + 16 * ks + 8 * hi); acc = mfma32(a, bb, acc); }
      bf16_t* out = (bf16_t*)(p.ws + WS_KCC) + (size_t)(kv * 64 + bg) * 128 * 64;
#pragma unroll
      for (int r = 0; r < 16; ++r) out[(32 * mt2 + crow(r, hi)) * 64 + 32 * nt2 + i] = (bf16_t)f2bf(acc[r]); }
    __syncthreads();
}

constexpr int HG_LF = 0, HG_TOT = 32768, HG_DEC = 34816, HG_QT = 35328, HG_KH = 52736, HG_KHT = 70144, HG_VT = 88576, HG_ST = 97792, HG_AM = 115200, HG_OF = 124416;
__device__ __forceinline__ void hgrn_unit(const Params& p, int l, int unit, lptr L) {
    int tid_ = threadIdx.x; asm volatile("" : "+v"(tid_)); const int tid = tid_, lane = tid & 63, w = __builtin_amdgcn_readfirstlane(tid >> 6), i = lane & 31, hi = lane >> 5;
    const int b = unit >> 3, hh = (unit >> 1) & 3, half = unit & 1;
    bf16_t* H = (bf16_t*)(p.ws + WS_H);
    const int t = tid >> 3, ds = tid & 7, d0 = ds * 16;
    LAS float* LF = (LAS float*)(L + HG_LF); LAS float* TOT = (LAS float*)(L + HG_TOT); LAS float* DEC = (LAS float*)(L + HG_DEC);
    LAS bf16_t* QT = (LAS bf16_t*)(L + HG_QT); LAS bf16_t* KH = (LAS bf16_t*)(L + HG_KH); LAS bf16_t* KHT = (LAS bf16_t*)(L + HG_KHT);
    LAS bf16_t* VT = (LAS bf16_t*)(L + HG_VT); LAS bf16_t* ST = (LAS bf16_t*)(L + HG_ST); LAS bf16_t* AM = (LAS bf16_t*)(L + HG_AM); LAS float* OF = (LAS float*)(L + HG_OF);
    float lbv[16];
#pragma unroll
    for (int e = 0; e < 16; ++e) { const int c = hh * 128 + d0 + e; lbv[e] = l == 0 ? 0.f : 1.0f / (1.0f + fexp(p.in[10][c] - p.in[10][512 + c])); }
    const int dkt = w & 3, dvt = w >> 2;
    f32x16 sacc = zero16();
    for (int c = 0; c < 32; ++c) {
        const size_t rowoff = (size_t)(b * SEQ + 64 * c + t) * HP;
        float qs[16], kk[16];
        {
            const u32x4 q0 = *(const u32x4*)(H + rowoff + C_QB + hh * 128 + d0), q1 = *(const u32x4*)(H + rowoff + C_QB + hh * 128 + d0 + 8);
            const u32x4 f0 = *(const u32x4*)(H + rowoff + C_FB + hh * 128 + d0), f1 = *(const u32x4*)(H + rowoff + C_FB + hh * 128 + d0 + 8);
            const u32x4 vv = *(const u32x4*)(H + rowoff + C_IB + hh * 128 + half * 64 + ds * 8);
            float zq[16], zf[16];
            zq[0] = bflo(q0.x); zq[1] = bfhi(q0.x); zq[2] = bflo(q0.y); zq[3] = bfhi(q0.y); zq[4] = bflo(q0.z); zq[5] = bfhi(q0.z); zq[6] = bflo(q0.w); zq[7] = bfhi(q0.w);
            zq[8] = bflo(q1.x); zq[9] = bfhi(q1.x); zq[10] = bflo(q1.y); zq[11] = bfhi(q1.y); zq[12] = bflo(q1.z); zq[13] = bfhi(q1.z); zq[14] = bflo(q1.w); zq[15] = bfhi(q1.w);
            zf[0] = bflo(f0.x); zf[1] = bfhi(f0.x); zf[2] = bflo(f0.y); zf[3] = bfhi(f0.y); zf[4] = bflo(f0.z); zf[5] = bfhi(f0.z); zf[6] = bflo(f0.w); zf[7] = bfhi(f0.w);
            zf[8] = bflo(f1.x); zf[9] = bfhi(f1.x); zf[10] = bflo(f1.y); zf[11] = bfhi(f1.y); zf[12] = bflo(f1.z); zf[13] = bfhi(f1.z); zf[14] = bflo(f1.w); zf[15] = bfhi(f1.w);
            float lf[16];
#pragma unroll
            for (int e = 0; e < 16; ++e) { qs[e] = zq[e] * sigmoidf_(zq[e]) * 0.08838834764831845f; const float f = lbv[e] + (1.0f - lbv[e]) * sigmoidf_(zf[e]); lf[e] = __logf(f); kk[e] = 1.0f - f; }
#pragma unroll
            for (int e4 = 0; e4 < 4; ++e4) *(LAS f32x4*)(LF + t * 128 + d0 + 4 * e4) = (f32x4){lf[4 * e4], lf[4 * e4 + 1], lf[4 * e4 + 2], lf[4 * e4 + 3]};
            const int dv0 = ds * 8;
            VT[(dv0 + 0) * 72 + t] = (bf16_t)(vv.x & 0xffff); VT[(dv0 + 1) * 72 + t] = (bf16_t)(vv.x >> 16); VT[(dv0 + 2) * 72 + t] = (bf16_t)(vv.y & 0xffff); VT[(dv0 + 3) * 72 + t] = (bf16_t)(vv.y >> 16);
            VT[(dv0 + 4) * 72 + t] = (bf16_t)(vv.z & 0xffff); VT[(dv0 + 5) * 72 + t] = (bf16_t)(vv.z >> 16); VT[(dv0 + 6) * 72 + t] = (bf16_t)(vv.w & 0xffff); VT[(dv0 + 7) * 72 + t] = (bf16_t)(vv.w >> 16);
        }
        __syncthreads();
        {
            const int d = tid & 127, seg = tid >> 7; float run = 0.f;
#pragma unroll
            for (int tt = 0; tt < 16; ++tt) { run += LF[(16 * seg + tt) * 128 + d]; LF[(16 * seg + tt) * 128 + d] = run; }
            TOT[seg * 128 + d] = run;
        }
        __syncthreads();
        {
            const int seg = t >> 4;
#pragma unroll
            for (int e4 = 0; e4 < 4; ++e4) {
                const f32x4 lfv = *(const LAS f32x4*)(LF + t * 128 + d0 + 4 * e4);
                const f32x4 t0 = *(const LAS f32x4*)(TOT + d0 + 4 * e4), t1 = *(const LAS f32x4*)(TOT + 128 + d0 + 4 * e4), t2 = *(const LAS f32x4*)(TOT + 256 + d0 + 4 * e4), t3 = *(const LAS f32x4*)(TOT + 384 + d0 + 4 * e4);
                f32x4 pre = (f32x4){0.f, 0.f, 0.f, 0.f}; if (seg > 0) pre = pre + t0; if (seg > 1) pre = pre + t1; if (seg > 2) pre = pre + t2;
                const f32x4 bt = lfv + pre, bl = (t0 + t1) + (t2 + t3);
                unsigned qw[4], kw[4];
#pragma unroll
                for (int e = 0; e < 4; ++e) { const float dq = fminf(bt[e] - bl[e], 80.f); const float qv = qs[4 * e4 + e] * fexp(dq), kvv = kk[4 * e4 + e] * fexp(bl[e] - bt[e]);
                    qw[e] = f2bf(qv); kw[e] = f2bf(kvv); KHT[(d0 + 4 * e4 + e) * 72 + t] = (bf16_t)kw[e];
                    if (t == 0) DEC[d0 + 4 * e4 + e] = fexp(bl[e]); }
                *(LAS u32x2*)(QT + t * 136 + d0 + 4 * e4) = (u32x2){qw[0] | (qw[1] << 16), qw[2] | (qw[3] << 16)};
                *(LAS u32x2*)(KH + t * 136 + d0 + 4 * e4) = (u32x2){kw[0] | (kw[1] << 16), kw[2] | (kw[3] << 16)};
            }
        }
        __syncthreads();
        {
#pragma unroll
            for (int r = 0; r < 16; ++r) sacc[r] *= DEC[32 * dkt + crow(r, hi)];
#pragma unroll
            for (int m = 0; m < 4; ++m) *(LAS u32x2*)(ST + (32 * dvt + i) * 136 + 32 * dkt + 8 * m + 4 * hi) = (u32x2){pk2(sacc[4 * m], sacc[4 * m + 1]), pk2(sacc[4 * m + 2], sacc[4 * m + 3])};
            if (w >= 4 && w < 7) { const int tm = (w - 4) == 0 ? 0 : 1, tn = (w - 4) == 2 ? 1 : 0; f32x16 am = zero16();
#pragma unroll
                for (int ks = 0; ks < 8; ++ks) { const bf16x8 a = *(const LAS bf16x8*)(QT + (32 * tm + i) * 136 + 16 * ks + 8 * hi), bb = *(const LAS bf16x8*)(KH + (32 * tn + i) * 136 + 16 * ks + 8 * hi); am = mfma32(a, bb, am); }
#pragma unroll
                for (int r = 0; r < 16; ++r) { const int tt = 32 * tm + crow(r, hi), ss = 32 * tn + i; AM[tt * 72 + ss] = (bf16_t)f2bf(ss <= tt ? am[r] : 0.f); } }
        }
        __syncthreads();
        {
            if (w < 4) { const int mt = w & 1, nt = w >> 1; f32x16 o = zero16();
#pragma unroll
                for (int ks = 0; ks < 8; ++ks) { const bf16x8 a = *(const LAS bf16x8*)(QT + (32 * mt + i) * 136 + 16 * ks + 8 * hi), bb = *(const LAS bf16x8*)(ST + (32 * nt + i) * 136 + 16 * ks + 8 * hi); o = mfma32(a, bb, o); }
#pragma unroll
                for (int ks = 0; ks < 4; ++ks) if (ks < 2 || mt == 1) { const bf16x8 a = *(const LAS bf16x8*)(AM + (32 * mt + i) * 72 + 16 * ks + 8 * hi), bb = *(const LAS bf16x8*)(VT + (32 * nt + i) * 72 + 16 * ks + 8 * hi); o = mfma32(a, bb, o); }
#pragma unroll
                for (int r = 0; r < 16; ++r) OF[(32 * mt + crow(r, hi)) * 64 + 32 * nt + i] = o[r]; }
#pragma unroll
            for (int ks = 0; ks < 4; ++ks) { const bf16x8 a = *(const LAS bf16x8*)(KHT + (32 * dkt + i) * 72 + 16 * ks + 8 * hi), bb = *(const LAS bf16x8*)(VT + (32 * dvt + i) * 72 + 16 * ks + 8 * hi); sacc = mfma32(a, bb, sacc); }
        }
        __syncthreads();
        {
            const f32x4 o0 = *(const LAS f32x4*)(OF + t * 64 + ds * 8), o1 = *(const LAS f32x4*)(OF + t * 64 + ds * 8 + 4);
            *(u32x4*)(H + rowoff + C_IB + hh * 128 + half * 64 + ds * 8) = pack8(o0, o1);
        }
    }
    __syncthreads();
}
__device__ __forceinline__ void hgrn_norm_rows(const Params& p, int l) {
    int tid_ = threadIdx.x; asm volatile("" : "+v"(tid_)); const int tid = tid_, lane = tid & 63, wave = tid >> 6; const int gw = blockIdx.x * 8 + wave, NGW = gridDim.x * 8;
    bf16_t* H = (bf16_t*)(p.ws + WS_H); const float* ng = p.in[11] + l * 128 + (lane & 15) * 8;
    const f32x4 n0 = *(const f32x4*)ng, n1 = *(const f32x4*)(ng + 4);
    for (int row = gw; row < NT; row += NGW) {
        bf16_t* op = H + (size_t)row * HP + C_IB + lane * 8; const u32x4 ov = *(const u32x4*)op, gv = *(const u32x4*)(H + (size_t)row * HP + C_GB + lane * 8);
        float o[8] = {bflo(ov.x), bfhi(ov.x), bflo(ov.y), bfhi(ov.y), bflo(ov.z), bfhi(ov.z), bflo(ov.w), bfhi(ov.w)};
        float gg[8] = {bflo(gv.x), bfhi(gv.x), bflo(gv.y), bfhi(gv.y), bflo(gv.z), bfhi(gv.z), bflo(gv.w), bfhi(gv.w)};
        float ss = 0.f;
#pragma unroll
        for (int e = 0; e < 8; ++e) ss += o[e] * o[e];
        ss += __shfl_xor(ss, 1); ss += __shfl_xor(ss, 2); ss += __shfl_xor(ss, 4); ss += __shfl_xor(ss, 8);
        const float rs = 1.0f / sqrtf(ss * (1.0f / 128.0f) + RMS_EPS);
        f32x4 r0, r1;
#pragma unroll
        for (int e = 0; e < 4; ++e) { r0[e] = o[e] * rs * n0[e] * (gg[e] * sigmoidf_(gg[e])); r1[e] = o[4 + e] * rs * n1[e] * (gg[4 + e] * sigmoidf_(gg[4 + e])); }
        *(u32x4*)op = pack8(r0, r1);
    }
}

constexpr int AT_K = 0, AT_V = 18432, AT_IMP = 36864, AT_SEL = 69632, AT_WSF = 69888, AT_PITCH = 144;
struct TileRegs { u32x4 k, v; };
__device__ __forceinline__ TileRegs attn_load_tile(const bf16_t* kbase, const bf16_t* vbase, int tile, int tid) {
    TileRegs r; const size_t off = (size_t)(64 * tile + (tid >> 3)) * HP + (tid & 7) * 8; r.k = *(const u32x4*)(kbase + off); r.v = *(const u32x4*)(vbase + off); return r;
}
__device__ __forceinline__ void attn_store_tile(lptr L, const TileRegs& r, int tid) {
    const int o = (tid >> 3) * AT_PITCH + (tid & 7) * 16; *(LAS u32x4*)(L + AT_K + o) = r.k; *(LAS u32x4*)(L + AT_V + o) = r.v;
}
__device__ __forceinline__ void attn_qk(lptr L, int krow0, const bf16x8 (&qr)[4], f32x16& p0, f32x16& p1, int i, int hi) {
    const lptr kb = L + AT_K + (krow0 + i) * AT_PITCH + hi * 16; p0 = zero16(); p1 = zero16();
#pragma unroll
    for (int ks = 0; ks < 4; ++ks) { const bf16x8 k0 = *(const LAS bf16x8*)(kb + ks * 32), k1 = *(const LAS bf16x8*)(kb + 32 * AT_PITCH + ks * 32);
        p0 = mfma32(k0, qr[ks], p0); p1 = mfma32(k1, qr[ks], p1); }
}
__device__ __forceinline__ bf16x8 pack_p(const f32x16& p, int base) {
    u32x4 w; w.x = pk2(p[base], p[base + 1]); w.y = pk2(p[base + 2], p[base + 3]); w.z = pk2(p[base + 4], p[base + 5]); w.w = pk2(p[base + 6], p[base + 7]); return __builtin_bit_cast(bf16x8, w);
}
__device__ __forceinline__ void attn_pv16(lptr L, int vrow0, bf16x8 pa, f32x16 (&o)[2], int lane) {
    const int hi = lane >> 5;
    const lptr vb = L + AT_V + (vrow0 + 4 * hi + ((lane & 15) >> 2)) * AT_PITCH + ((lane >> 4) & 1) * 32 + (lane & 3) * 8;
#pragma unroll
    for (int d0 = 0; d0 < 2; ++d0) {
        const s16x4 lo = __builtin_bit_cast(s16x4, __builtin_amdgcn_ds_read_tr16_b64_v4i16((LAS s16x4*)(vb + d0 * 64)));
        const s16x4 up = __builtin_bit_cast(s16x4, __builtin_amdgcn_ds_read_tr16_b64_v4i16((LAS s16x4*)(vb + 8 * AT_PITCH + d0 * 64)));
        const bf16x8 bb = (bf16x8){lo[0], lo[1], lo[2], lo[3], up[0], up[1], up[2], up[3]};
        o[d0] = mfma32(pa, bb, o[d0]);
    }
}
struct SoftState { float m, l; f32x16 o[2]; };
__device__ __forceinline__ void attn_tile_step(lptr L, const bf16x8 (&qr)[4], SoftState& st, int mode, bool allowed, int tq, LAS float* wsf, int lane) {
    const int i = lane & 31, hi = lane >> 5; const float NEG = -__builtin_inff();
    f32x16 p0, p1; attn_qk(L, 0, qr, p0, p1, i, hi);
#pragma unroll
    for (int r = 0; r < 16; ++r) { const int k0 = crow(r, hi), k1 = k0 + 32;
        bool a0 = allowed, a1 = allowed;
        if (mode == 1) { a0 = a0 && (k0 <= tq); a1 = a1 && (k1 <= tq); }
        if (mode == 2) { a0 = a0 && (k0 > tq); a1 = a1 && (k1 > tq); }
        p0[r] = a0 ? p0[r] : NEG; p1[r] = a1 ? p1[r] : NEG; }
    float mx = NEG;
#pragma unroll
    for (int r = 0; r < 16; ++r) mx = fmaxf(mx, fmaxf(p0[r], p1[r]));
    mx = fmaxf(mx, __shfl_xor(mx, 32));
    const float mnew = fmaxf(st.m, mx), muse = (mnew == NEG) ? 0.f : mnew;
    const float alpha = __builtin_amdgcn_exp2f(st.m - muse);
    float rs = 0.f;
#pragma unroll
    for (int r = 0; r < 16; ++r) { p0[r] = __builtin_amdgcn_exp2f(p0[r] - muse); p1[r] = __builtin_amdgcn_exp2f(p1[r] - muse); rs += p0[r] + p1[r]; }
    rs += __shfl_xor(rs, 32);
    st.l = st.l * alpha + rs; st.m = mnew;
    if (hi == 0) wsf[i] = alpha;
    asm volatile("s_waitcnt lgkmcnt(0)" ::: "memory");
#pragma unroll
    for (int r = 0; r < 16; ++r) { const float a = wsf[crow(r, hi)]; st.o[0][r] *= a; st.o[1][r] *= a; }
    attn_pv16(L, 0, pack_p(p0, 0), st.o, lane); attn_pv16(L, 16, pack_p(p0, 8), st.o, lane);
    attn_pv16(L, 32, pack_p(p1, 0), st.o, lane); attn_pv16(L, 48, pack_p(p1, 8), st.o, lane);
}
__device__ __forceinline__ void attn_finish_branch(const SoftState& st, float gate, f32x16 (&yacc)[2], LAS float* wsf, int lane) {
    const int i = lane & 31, hi = lane >> 5;
    if (hi == 0) wsf[i] = gate / fmaxf(st.l, 1e-30f);
    asm volatile("s_waitcnt lgkmcnt(0)" ::: "memory");
#pragma unroll
    for (int r = 0; r < 16; ++r) { const float a = wsf[crow(r, hi)]; yacc[0][r] += st.o[0][r] * a; yacc[1][r] += st.o[1][r] * a; }
}

__device__ __forceinline__ void attn_unit(const Params& p, int bg, int qb, lptr L) {
    int tid_ = threadIdx.x; asm volatile("" : "+v"(tid_)); const int tid = tid_, lane = tid & 63, w = __builtin_amdgcn_readfirstlane(tid >> 6), i = lane & 31, hi = lane >> 5;
    const int b = bg >> 1, g = bg & 1, rh = w >> 1, tq = 32 * (w & 1) + i;
    bf16_t* H = (bf16_t*)(p.ws + WS_H);
    const size_t seqbase = (size_t)b * SEQ * HP;
    bf16_t* qrow = H + seqbase + (size_t)(64 * qb + tq) * HP;
    LAS float* wsf = (LAS float*)(L + AT_WSF) + w * 32;
    LAS float* IMP = (LAS float*)(L + AT_IMP);
    LAS unsigned* SELM = (LAS unsigned*)(L + AT_SEL);
    { const bf16_t* kc = (const bf16_t*)(p.ws + WS_KCC) + (size_t)bg * 128 * 64; const bf16_t* vc = kc + (size_t)64 * 128 * 64;
#pragma unroll
      for (int h2 = 0; h2 < 2; ++h2) { const int row = (tid >> 3) + 64 * h2, o = row * AT_PITCH + (tid & 7) * 16;
          *(LAS u32x4*)(L + AT_K + o) = *(const u32x4*)(kc + row * 64 + (tid & 7) * 8); *(LAS u32x4*)(L + AT_V + o) = *(const u32x4*)(vc + row * 64 + (tid & 7) * 8); } }
    bf16x8 qr[4];
#pragma unroll
    for (int ks = 0; ks < 4; ++ks) qr[ks] = *(const bf16x8*)(qrow + C_QA + (g * 4 + rh) * 64 + 16 * ks + 8 * hi);
    float gate[3];
#pragma unroll
    for (int br = 0; br < 3; ++br) gate[br] = sigmoidf_(bf2f(qrow[C_GATE + (g * 4 + rh) * 3 + br]));
    f32x16 yacc[2]; yacc[0] = zero16(); yacc[1] = zero16();
    const float NEG = -__builtin_inff();
    __syncthreads();
    {
        f32x16 pc[4];
        attn_qk(L, 0, qr, pc[0], pc[1], i, hi); attn_qk(L, 64, qr, pc[2], pc[3], i, hi);
        const int tpos = 64 * qb + tq; float mx = NEG;
#pragma unroll
        for (int kt = 0; kt < 4; ++kt)
#pragma unroll
            for (int r = 0; r < 16; ++r) { const int n = 32 * kt + crow(r, hi); pc[kt][r] = (16 * n + 31 <= tpos) ? pc[kt][r] : NEG; mx = fmaxf(mx, pc[kt][r]); }
        mx = fmaxf(mx, __shfl_xor(mx, 32)); const float muse = (mx == NEG) ? 0.f : mx; float rs = 0.f;
#pragma unroll
        for (int kt = 0; kt < 4; ++kt)
#pragma unroll
            for (int r = 0; r < 16; ++r) { pc[kt][r] = __builtin_amdgcn_exp2f(pc[kt][r] - muse); rs += pc[kt][r]; }
        rs += __shfl_xor(rs, 32); const float inv = 1.0f / fmaxf(rs, 1e-30f);
        float prev = 0.f;
#pragma unroll
        for (int kt = 0; kt < 4; ++kt) {
#pragma unroll
            for (int r = 0; r < 16; ++r) pc[kt][r] *= inv;
#pragma unroll
            for (int m = 0; m < 4; ++m) { const float G4 = (pc[kt][4 * m] + pc[kt][4 * m + 1]) + (pc[kt][4 * m + 2] + pc[kt][4 * m + 3]); const float yy = __shfl_xor(pc[kt][4 * m + 3], 32);
                const float val = hi ? (G4 + yy) : (G4 + prev); prev = yy; IMP[(rh * 64 + tq) * 32 + 8 * kt + 2 * m + hi] = val; } }
        SoftState sc; sc.m = 0.f; sc.l = 1.f; sc.o[0] = zero16(); sc.o[1] = zero16();
#pragma unroll
        for (int kt = 0; kt < 4; ++kt) { attn_pv16(L, 32 * kt, pack_p(pc[kt], 0), sc.o, lane); attn_pv16(L, 32 * kt + 16, pack_p(pc[kt], 8), sc.o, lane); }
        attn_finish_branch(sc, gate[0], yacc, wsf, lane);
    }
    __syncthreads();
    if (tid < 64) {
        float sc[32];
#pragma unroll
        for (int j = 0; j < 32; ++j) { if ((j & 7) == 0) asm volatile("" ::: "memory"); const float s = (IMP[(0 * 64 + tid) * 32 + j] + IMP[(1 * 64 + tid) * 32 + j]) + (IMP[(2 * 64 + tid) * 32 + j] + IMP[(3 * 64 + tid) * 32 + j]);
            const bool valid = j <= qb, forced = valid && (j == 0 || j == qb || j == qb - 1); sc[j] = forced ? 1.0e4f : (valid ? s : -1.0f); }
        unsigned mask = 0u;
#pragma unroll
        for (int it = 0; it < 8; ++it) { float best = -3.0e38f; int bi = 0;
#pragma unroll
            for (int j = 0; j < 32; ++j) { const float v = ((mask >> j) & 1u) ? -3.0e38f : sc[j]; if (v > best) { best = v; bi = j; } }
            mask |= 1u << bi; }
        const unsigned vm = qb >= 31 ? 0xffffffffu : ((2u << qb) - 1u);
        SELM[tid] = mask & vm;
    }
    __syncthreads();
    const unsigned selm = SELM[tq];
    unsigned anysel = SELM[lane];
#pragma unroll
    for (int o = 1; o < 64; o <<= 1) anysel |= __shfl_xor(anysel, o);
    anysel = __builtin_amdgcn_readfirstlane(anysel);
    {
        const bf16_t* kb = H + seqbase + C_KS + g * 64; const bf16_t* vb = H + seqbase + C_VS + g * 64;
        SoftState st; st.m = NEG; st.l = 0.f; st.o[0] = zero16(); st.o[1] = zero16();
        unsigned tiles = anysel;
        TileRegs tr = attn_load_tile(kb, vb, __builtin_ctz(tiles), tid);
        while (tiles) { const int j = __builtin_ctz(tiles); tiles &= tiles - 1;
            attn_store_tile(L, tr, tid); __syncthreads();
            if (tiles) tr = attn_load_tile(kb, vb, __builtin_ctz(tiles), tid);
            attn_tile_step(L, qr, st, j == qb ? 1 : 0, ((selm >> j) & 1u) != 0u, tq, wsf, lane);
            __syncthreads(); }
        attn_finish_branch(st, gate[1], yacc, wsf, lane);
    }
    {
        const bf16_t* kb = H + seqbase + C_KW + g * 64; const bf16_t* vb = H + seqbase + C_VW + g * 64;
        SoftState st; st.m = NEG; st.l = 0.f; st.o[0] = zero16(); st.o[1] = zero16();
        const int jlo = qb >= 8 ? qb - 8 : 0;
        TileRegs tr = attn_load_tile(kb, vb, jlo, tid);
        for (int j = jlo; j <= qb; ++j) {
            attn_store_tile(L, tr, tid); __syncthreads();
            if (j < qb) tr = attn_load_tile(kb, vb, j + 1, tid);
            attn_tile_step(L, qr, st, j == qb ? 1 : (qb - j == 8 ? 2 : 0), true, tq, wsf, lane);
            __syncthreads(); }
        attn_finish_branch(st, gate[2], yacc, wsf, lane);
    }
    { bf16_t* yb = H + seqbase + (size_t)(64 * qb + 32 * (w & 1)) * HP + C_QA + (g * 4 + rh) * 64;
#pragma unroll
      for (int d0 = 0; d0 < 2; ++d0)
#pragma unroll
          for (int r = 0; r < 16; ++r) yb[(size_t)crow(r, hi) * HP + 32 * d0 + i] = (bf16_t)f2bf(yacc[d0][r]); }
    __syncthreads();
}

__global__ void __launch_bounds__(512, 2) nsa_hgrn_fwd(Params p) {
    extern __shared__ __attribute__((aligned(16))) unsigned char lds_raw[];
    const lptr L = (lptr)lds_raw;
    cg::grid_group grid = cg::this_grid();
    unsigned char* ws = p.ws;
    const int G = gridDim.x;
    int ph = 0;
#ifndef PH_LO
#define PH_LO 0
#endif
#ifndef PH_HI
#define PH_HI 1000
#endif
#define PHASE_BEGIN if (ph >= PH_LO && ph < PH_HI) {
#define PHASE_END } ++ph; if (ph > PH_LO && ph < PH_HI) grid.sync();
    bf16_t* ACT = (bf16_t*)(ws + WS_ACT); bf16_t* H = (bf16_t*)(ws + WS_H); float* Y = (float*)(ws + WS_Y);
    const float* modb = (const float*)(ws + WS_MOD);

    PHASE_BEGIN
#ifndef NO_PRO
 phase_prologue(p, L);
#endif
 PHASE_END
    PHASE_BEGIN phase_modulate(p, p.in[0], 0); PHASE_END
    for (int l = 0; l < 2; ++l) {
        const float* mod = modb + (size_t)l * 32 * 6144;
        PHASE_BEGIN
            pg8::Gemm g{ACT, (const bf16_t*)(ws + WS_WIN) + (size_t)l * NINP * 1024, NT, NINP, 1024, 1024, 1024}; pg8::StaticOrder S; S.init(NT, NINP, G, (int)blockIdx.x);
#ifndef NO_GEMM
            EpiInProj E{H, (const float*)(ws + WS_BIAS) + l * NINP, (const float*)(ws + WS_COS), (const float*)(ws + WS_SIN)};
            pg8::gemm_phase(L, g, S, E);
#endif
        PHASE_END
        PHASE_BEGIN
#ifndef NO_HGRN
            for (int u = blockIdx.x; u < 256; u += G) hgrn_unit(p, l, u, L);
#endif
#ifndef NO_CMP
            for (int u = blockIdx.x; u < 128; u += G) compress_unit(p, l, u, L);
#endif
        PHASE_END
        PHASE_BEGIN
            hgrn_norm_rows(p, l);
#ifndef NO_ATTN
            for (int u = blockIdx.x; u < 2048; u += G) { const int c = u & 255, rnd = u >> 8, s = c & 3; const int qb = (rnd & 1) ? 8 * (rnd >> 1) + 7 - s : 8 * (rnd >> 1) + s; attn_unit(p, c >> 2, qb, L); }
#endif
        PHASE_END
        PHASE_BEGIN
            pg8::Gemm g{H + C_QA, (const bf16_t*)(ws + WS_WBA) + (size_t)l * 1024 * 512, NT, 1024, 512, HP, 512}; pg8::StaticOrder S; S.init(NT, 1024, G, (int)blockIdx.x);
            EpiBranch<0> E{ACT, H + C_GMA};
#ifndef NO_G2
 pg8::gemm_phase(L, g, S, E);
#endif

        PHASE_END
        PHASE_BEGIN
            pg8::Gemm g{H + C_IB, (const bf16_t*)(ws + WS_WBB) + (size_t)l * 1024 * 512, NT, 1024, 512, HP, 512}; pg8::StaticOrder S; S.init(NT, 1024, G, (int)blockIdx.x);
            EpiBranch<1> E{ACT, H + C_GMB};
#ifndef NO_G3
 pg8::gemm_phase(L, g, S, E);
#endif

        PHASE_END
        PHASE_BEGIN
            pg8::Gemm g{ACT, (const bf16_t*)(ws + WS_WOUT) + (size_t)l * 1024 * 1024, NT, 1024, 1024, 1024, 1024}; pg8::StaticOrder S; S.init(NT, 1024, G, (int)blockIdx.x);
            EpiF32 E{Y};
#ifndef NO_G4
 pg8::gemm_phase(L, g, S, E);
#endif

        PHASE_END
        PHASE_BEGIN
            phase_ln(p, l == 0 ? p.in[0] : p.out, Y, p.out, mod + 2048, p.in[17] + l * 1024, p.in[18] + l * 1024, mod + 3072, mod + 4096);
        PHASE_END
        PHASE_BEGIN
            pg8::Gemm g{ACT, (const bf16_t*)(ws + WS_W1) + (size_t)l * 4096 * 1024, NT, FF, 1024, 1024, 1024}; pg8::StaticOrder S; S.init(NT, FF, G, (int)blockIdx.x);
            EpiRelu2 E{H};
#ifndef NO_G5
 pg8::gemm_phase(L, g, S, E);
#endif

        PHASE_END
        PHASE_BEGIN
            pg8::Gemm g{H, (const bf16_t*)(ws + WS_W2) + (size_t)l * 1024 * 4096, NT, 1024, FF, FF, FF}; pg8::StaticOrder S; S.init(NT, 1024, G, (int)blockIdx.x);
            EpiF32 E{Y};
#ifndef NO_G4
 pg8::gemm_phase(L, g, S, E);
#endif

        PHASE_END
        PHASE_BEGIN
            const float* nm = modb + (size_t)32 * 6144;
            phase_ln(p, p.out, Y, p.out, mod + 5120, p.in[21] + l * 1024, p.in[22] + l * 1024, l == 0 ? nm : nullptr, l == 0 ? nm + 1024 : nullptr);
        PHASE_END
    }
}

extern "C" void kernel_launch(void* const* d_in, const int* in_sizes, int n_in, void* d_out, int out_size, void* d_ws, size_t ws_size, hipStream_t stream) {
    static int grid = 0;
    if (grid == 0) {
        if (n_in != 23 || out_size != NT * DM || ws_size < WS_END) { fprintf(stderr, "kernel_launch: unexpected shapes (n_in %d out %d ws %zu)\n", n_in, out_size, ws_size); grid = -1; return; }
        int dev = 0, cus = 0, per_cu = 0;
        hipGetDevice(&dev); hipDeviceGetAttribute(&cus, hipDeviceAttributeMultiprocessorCount, dev);
        hipFuncSetAttribute((const void*)nsa_hgrn_fwd, hipFuncAttributeMaxDynamicSharedMemorySize, LDS_BYTES);
        hipOccupancyMaxActiveBlocksPerMultiprocessor(&per_cu, (const void*)nsa_hgrn_fwd, 512, LDS_BYTES);
        if (per_cu < 1) { fprintf(stderr, "kernel_launch: occupancy query says %d blocks per CU\n", per_cu); per_cu = 1; }
        (void)hipGetLastError();
        grid = cus;
        if (grid > 256) grid = 256;
    }
    if (grid < 0) return;
    Params p{};
    for (int i = 0; i < 23; ++i) p.in[i] = (const float*)d_in[i];
    p.out = (float*)d_out; p.ws = (unsigned char*)d_ws; p.ph_lo = 0; p.ph_hi = 1000;
    void* args[] = {&p};
    hipError_t e = hipLaunchCooperativeKernel((const void*)nsa_hgrn_fwd, dim3(grid), dim3(512), args, LDS_BYTES, stream);
    if (e != hipSuccess) fprintf(stderr, "cooperative launch failed: %s (grid %d)\n", hipGetErrorString(e), grid);
}
```

```cpp
#include <hip/hip_runtime.h>
#include <hip/hip_cooperative_groups.h>
#include <cstdio>
#include <cstdint>
namespace cg = cooperative_groups;

#define LAS __attribute__((address_space(3)))
typedef unsigned short bf16_t;
typedef short bf16x8 __attribute__((ext_vector_type(8)));
typedef short s16x4 __attribute__((ext_vector_type(4)));
typedef float f32x4 __attribute__((ext_vector_type(4)));
typedef float f32x2 __attribute__((ext_vector_type(2)));
typedef float f32x16 __attribute__((ext_vector_type(16)));
typedef unsigned u32x4 __attribute__((ext_vector_type(4)));
typedef unsigned u32x2 __attribute__((ext_vector_type(2)));
typedef LAS unsigned char* lptr;

constexpr int DM = 1024, NB = 32, SEQ = 2048, NT = NB * SEQ, FF = 4096, NIN = 5400, NINP = 5632, HP = 5400;
constexpr int C_QA = 0, C_KC = 512, C_KS = 640, C_KW = 768, C_VC = 896, C_VS = 1024, C_VW = 1152, C_GATE = 1280, C_QB = 1304, C_FB = 1816,
              C_IB = 2328, C_GB = 2840, C_GMA = 3352, C_GMB = 4376;
constexpr float QSCALE = 0.125f * 1.4426950408889634f;
constexpr float LN_EPS = 1e-5f, RMS_EPS = 1e-6f, DN_ALPHA = 1.4142135623730951f;
constexpr size_t MiB = 1u << 20;
constexpr size_t WS_MOD = 0;
constexpr size_t WS_COS = 2 * MiB;
constexpr size_t WS_SIN = 2 * MiB + 512 * 1024;
constexpr size_t WS_BIAS = 3 * MiB;
constexpr size_t WS_C1 = 3 * MiB + 256 * 1024;
constexpr size_t WS_KCC = 4 * MiB;
constexpr size_t WS_WIN = 8 * MiB;
constexpr size_t WS_WBA = 30 * MiB;
constexpr size_t WS_WBB = 32 * MiB;
constexpr size_t WS_WOUT = 34 * MiB;
constexpr size_t WS_W1 = 38 * MiB;
constexpr size_t WS_W2 = 54 * MiB;
constexpr size_t WS_CW1 = 70 * MiB;
constexpr size_t WS_CW2 = 72 * MiB;
constexpr size_t WS_ACT = 74 * MiB;
constexpr size_t WS_H = 202 * MiB;
constexpr size_t WS_Y = 714 * MiB;
constexpr size_t WS_END = 970 * MiB;
constexpr int LDS_BYTES = 147456;

struct Params {
    const float* in[23];
    float* out;
    unsigned char* ws;
    int ph_lo, ph_hi;
};

__device__ __forceinline__ unsigned f2bf(float f) { unsigned u = __builtin_bit_cast(unsigned, f); return (u + 0x7fffu + ((u >> 16) & 1u)) >> 16; }
typedef __bf16 hwbf16x2 __attribute__((ext_vector_type(2)));
__device__ __forceinline__ unsigned pk2(float lo, float hi) { f32x2 v = {lo, hi}; hwbf16x2 b = __builtin_convertvector(v, hwbf16x2); return __builtin_bit_cast(unsigned, b); }
__device__ __forceinline__ float bflo(unsigned w) { return __builtin_bit_cast(float, w << 16); }
__device__ __forceinline__ float bfhi(unsigned w) { return __builtin_bit_cast(float, w & 0xffff0000u); }
__device__ __forceinline__ float bf2f(bf16_t b) { return __builtin_bit_cast(float, (unsigned)b << 16); }
__device__ __forceinline__ float fexp(float x) { return __builtin_amdgcn_exp2f(x * 1.4426950408889634f); }
__device__ __forceinline__ float sigmoidf_(float x) { return 1.0f / (1.0f + fexp(-x)); }
#define LDS_BARRIER() asm volatile("s_waitcnt lgkmcnt(0)\n\ts_barrier" ::: "memory")
__device__ __forceinline__ int crow(int r, int hi) { return (r & 3) + 8 * (r >> 2) + 4 * hi; }
__device__ __forceinline__ int dmap(int c) { return (c >> 1) + 32 * (c & 1); }
__device__ __forceinline__ f32x16 mfma32(bf16x8 a, bf16x8 b, f32x16 c) { return __builtin_amdgcn_mfma_f32_32x32x16_bf16(a, b, c, 0, 0, 0); }
__device__ __forceinline__ f32x16 zero16() { return (f32x16){0.f,0.f,0.f,0.f,0.f,0.f,0.f,0.f,0.f,0.f,0.f,0.f,0.f,0.f,0.f,0.f}; }
__device__ __forceinline__ float wave_sum(float v) {
#pragma unroll
    for (int o = 1; o < 64; o <<= 1) v += __shfl_xor(v, o);
    return v;
}

namespace pg8 {
constexpr int BM = 256, BK = 64, HALF = 128, HTB = HALF * BK * 2, STAGE_BYTES = 8 * HTB, NXCD = 8, WGM = 8;
__host__ __device__ __forceinline__ int lds_byte(int r, int c) { const int st = (r >> 4) * 2 + (c >> 5), rr = r & 15, cc = c & 31, ob = rr * 64 + cc * 2; return st * 1024 + (ob ^ (((ob >> 9) & 1) << 5)); }
__host__ __device__ __forceinline__ void stage_rc(int b, int& R, int& C) { const int st = b / 1024, sb = b % 1024, swz = sb ^ (((sb >> 9) & 1) << 5); R = (st >> 1) * 16 + swz / 64; C = (st & 1) * 32 + (swz % 64) / 2; }
__host__ __device__ __forceinline__ int perm32(int rho) { const int n = rho >> 4, i = rho & 15; return 8 * (i >> 2) + 4 * n + (i & 3); }
struct Unit { int pm, pn; };
struct Gemm { const bf16_t* A; const bf16_t* Bt; int M, N, K, lda, ldb; };
struct StaticOrder {
    int nM, nN, nwg, G, c;
    __host__ __device__ void init(int M, int N, int G_, int c_) { nM = M / BM; nN = N / BM; nwg = nM * nN; G = G_; c = c_; }
    __host__ __device__ bool next(int i, Unit& u) const {
        const long L = (long)i * G + c; if (L >= nwg) return false;
        int wgid = (int)L; { const int q = nwg / NXCD, r = nwg % NXCD, xcd = wgid % NXCD, off = wgid / NXCD; wgid = (xcd < r ? xcd * (q + 1) : r * (q + 1) + (xcd - r) * q) + off; }
        const int nig = WGM * nN, gid = wgid / nig, fm = gid * WGM, gsz = (nM - fm) < WGM ? (nM - fm) : WGM;
        u.pm = fm + ((wgid % nig) % gsz); u.pn = (wgid % nig) / gsz; return true;
    }
};
template <class Epi>
__device__ __forceinline__ void gemm_phase(LAS unsigned char* lds, const Gemm g, const StaticOrder& S, const Epi& E) {
    int tid_ = threadIdx.x; asm volatile("" : "+v"(tid_)); const int tid = tid_, wid = __builtin_amdgcn_readfirstlane(tid >> 6), lane = tid & 63, wr = wid >> 2, wc = wid & 3, fr = lane & 15, fq = lane >> 4;
    const int K = g.K, nt = K / BK;
    unsigned voffA[2], voffB[2];
#pragma unroll
    for (int i = 0; i < 2; ++i) { int R, C; stage_rc(tid * 16 + i * 8192, R, C); const int Rb = (R & ~31) + perm32(R & 31);
        voffA[i] = (unsigned)(R * g.lda + C) * 2u; voffB[i] = (unsigned)(Rb * g.ldb + C) * 2u; }
    const size_t kstep = (size_t)(BK * 2);
    const size_t hstepA = (size_t)HALF * g.lda * 2, hstepB = (size_t)HALF * g.ldb * 2;
    const size_t tstepA = 2 * hstepA, tstepB = 2 * hstepB;
    const unsigned ldsw = (unsigned)wid * 1024u;
    const int aoff = lds_byte(wr * 64 + fr, fq * 8), boff = lds_byte(wc * 32 + fr, fq * 8);
#define PG8_SA(b, h) (((b) * 2 + (h)) * HTB)
#define PG8_SB(b, h) ((4 + (b) * 2 + (h)) * HTB)
#define PG8_STAGE(bufoff, gbase, voff) do { _Pragma("unroll") for (int _i = 0; _i < 2; ++_i) \
        __builtin_amdgcn_global_load_lds((const unsigned*)((const char*)(gbase) + (voff)[_i]), (LAS unsigned*)(lds + (bufoff) + ldsw + _i * 8192), 16, 0, 0); } while (0)
#define PG8_LDA(dst, b, h) do { _Pragma("unroll") for (int m = 0; m < 4; ++m) _Pragma("unroll") for (int k = 0; k < 2; ++k) dst[m][k] = *(const LAS bf16x8*)(lds + PG8_SA(b, h) + aoff + m * 2048 + k * 1024); } while (0)
#define PG8_LDB(dst, b, h) do { _Pragma("unroll") for (int n = 0; n < 2; ++n) _Pragma("unroll") for (int k = 0; k < 2; ++k) dst[n][k] = *(const LAS bf16x8*)(lds + PG8_SB(b, h) + boff + n * 2048 + k * 1024); } while (0)
#define PG8_MMA(ai, bj, At, Bt) do { __builtin_amdgcn_s_setprio(1); _Pragma("unroll") for (int m = 0; m < 4; ++m) _Pragma("unroll") for (int n = 0; n < 2; ++n) _Pragma("unroll") for (int k = 0; k < 2; ++k) \
        acc[ai][bj][m][n] = __builtin_amdgcn_mfma_f32_16x16x32_bf16(Bt[n][k], At[m][k], acc[ai][bj][m][n], 0, 0, 0); __builtin_amdgcn_s_setprio(0); } while (0)
#define PG8_WAIT_V(n) asm volatile("s_waitcnt vmcnt(" #n ")" ::: "memory")
#define PG8_WAIT_L(n) asm volatile("s_waitcnt lgkmcnt(" #n ")" ::: "memory")
#define PG8_BAR __builtin_amdgcn_s_barrier()
#define PG8_SCHED __builtin_amdgcn_sched_barrier(0)
    Unit cur, nxt; int ui = 0;
    if (!S.next(0, cur)) return;
    f32x4 acc[2][2][4][2];
#pragma unroll
    for (int a = 0; a < 2; ++a)
#pragma unroll
        for (int b = 0; b < 2; ++b)
#pragma unroll
            for (int m = 0; m < 4; ++m)
#pragma unroll
                for (int n = 0; n < 2; ++n) acc[a][b][m][n] = (f32x4){0.f, 0.f, 0.f, 0.f};
    bf16x8 At[4][2], B0[2][2], B1[2][2];
    const char* cA = (const char*)g.A + (size_t)cur.pm * tstepA; const char* cB = (const char*)g.Bt + (size_t)cur.pn * tstepB;
    PG8_STAGE(PG8_SB(0, 0), cB, voffB); PG8_STAGE(PG8_SB(0, 1), cB + hstepB, voffB); PG8_STAGE(PG8_SA(0, 0), cA, voffA); PG8_STAGE(PG8_SA(0, 1), cA + hstepA, voffA);
    if (wr == 1) PG8_BAR;
    PG8_WAIT_V(2); PG8_BAR;
    PG8_STAGE(PG8_SB(1, 0), cB + kstep, voffB); PG8_STAGE(PG8_SA(1, 0), cA + kstep, voffA); PG8_STAGE(PG8_SB(1, 1), cB + hstepB + kstep, voffB);
    PG8_WAIT_V(6); PG8_BAR;
    for (;;) {
        const bool has_next = S.next(ui + 1, nxt);
        const char* nA = has_next ? (const char*)g.A + (size_t)nxt.pm * tstepA : cA; const char* nB = has_next ? (const char*)g.Bt + (size_t)nxt.pn * tstepB : cB;
        for (int t = 0; t < nt; t += 2) {
            const bool last = (t == nt - 2);
            const char* a1 = cA + (size_t)(t + 1) * kstep;
            const char* a2 = last ? nA : cA + (size_t)(t + 2) * kstep; const char* b2 = last ? nB : cB + (size_t)(t + 2) * kstep;
            const char* a3 = a2 + kstep; const char* b3 = b2 + kstep;
            PG8_LDB(B0, 0, 0); PG8_LDB(B1, 0, 1); PG8_SCHED; PG8_LDA(At, 0, 0); PG8_STAGE(PG8_SA(1, 1), a1 + hstepA, voffA);
            PG8_WAIT_V(8); PG8_WAIT_L(0); PG8_BAR; PG8_MMA(0, 0, At, B0); PG8_MMA(0, 1, At, B1); PG8_BAR; PG8_SCHED;
            PG8_LDA(At, 0, 1); PG8_STAGE(PG8_SB(0, 0), b2, voffB); PG8_STAGE(PG8_SB(0, 1), b2 + hstepB, voffB); PG8_STAGE(PG8_SA(0, 0), a2, voffA);
            PG8_WAIT_V(8); PG8_WAIT_L(0); PG8_BAR; PG8_MMA(1, 0, At, B0); PG8_MMA(1, 1, At, B1); PG8_BAR; PG8_SCHED;
            PG8_LDB(B0, 1, 0); PG8_LDB(B1, 1, 1); PG8_SCHED; PG8_LDA(At, 1, 0); PG8_STAGE(PG8_SA(0, 1), a2 + hstepA, voffA);
            PG8_WAIT_V(8); PG8_WAIT_L(0); PG8_BAR; PG8_MMA(0, 0, At, B0); PG8_MMA(0, 1, At, B1); PG8_BAR; PG8_SCHED;
            PG8_LDA(At, 1, 1); PG8_STAGE(PG8_SB(1, 0), b3, voffB); PG8_STAGE(PG8_SB(1, 1), b3 + hstepB, voffB); PG8_STAGE(PG8_SA(1, 0), a3, voffA);
            PG8_WAIT_V(8); PG8_WAIT_L(0); PG8_BAR; PG8_MMA(1, 0, At, B0); PG8_MMA(1, 1, At, B1); PG8_BAR; PG8_SCHED;
        }
        if (wr == 0) PG8_BAR;
        E(acc, cur, wr, wc, fr, fq);
        if (!has_next) break;
#pragma unroll
        for (int a = 0; a < 2; ++a)
#pragma unroll
            for (int b = 0; b < 2; ++b)
#pragma unroll
                for (int m = 0; m < 4; ++m)
#pragma unroll
                    for (int n = 0; n < 2; ++n) acc[a][b][m][n] = (f32x4){0.f, 0.f, 0.f, 0.f};
        cur = nxt; cA = nA; cB = nB; ++ui;
        if (wr == 1) PG8_BAR;
    }
    PG8_WAIT_V(0);
    PG8_BAR;
#undef PG8_SA
#undef PG8_SB
#undef PG8_STAGE
#undef PG8_LDA
#undef PG8_LDB
#undef PG8_MMA
#undef PG8_WAIT_V
#undef PG8_WAIT_L
#undef PG8_BAR
#undef PG8_SCHED
}
}

typedef f32x4 AccT[2][2][4][2];
#define EPI_LOOP_BEGIN \
    const int row0 = u.pm * 256 + wr * 64 + fr, colb = u.pn * 256 + wc * 32 + 8 * fq; \
    _Pragma("unroll") for (int bj = 0; bj < 2; ++bj) { const int col = colb + bj * 128;
#define EPI_ROWS_BEGIN \
    _Pragma("unroll") for (int ai = 0; ai < 2; ++ai) { asm volatile("" ::: "memory"); _Pragma("unroll") for (int m = 0; m < 4; ++m) { const int row = row0 + ai * 128 + m * 16; \
        f32x4 v0 = acc[ai][bj][m][0], v1 = acc[ai][bj][m][1];
#define EPI_END } } }
__device__ __forceinline__ u32x4 pack8(f32x4 v0, f32x4 v1) { u32x4 w; w.x = pk2(v0[0], v0[1]); w.y = pk2(v0[2], v0[3]); w.z = pk2(v1[0], v1[1]); w.w = pk2(v1[2], v1[3]); return w; }

struct EpiInProj {
    bf16_t* H; const float* bias; const float* cosT; const float* sinT;
    __device__ __forceinline__ void operator()(const AccT& acc, const pg8::Unit& u, int wr, int wc, int fr, int fq) const {
        EPI_LOOP_BEGIN
            if (col < NIN) {
                const f32x4 b0 = *(const f32x4*)(bias + col), b1 = *(const f32x4*)(bias + col + 4);
                const bool rope = col < C_VC; const int i0 = (col & 63) >> 1; const float qs = col < C_KC ? QSCALE : 1.0f;
                EPI_ROWS_BEGIN
                    v0 = v0 + b0; v1 = v1 + b1;
                    if (rope) {
                        const int pos = row & (SEQ - 1);
                        const f32x4 c4 = *(const f32x4*)(cosT + pos * 32 + i0), s4 = *(const f32x4*)(sinT + pos * 32 + i0);
                        f32x4 o0, o1;
                        o0[0] = v0[0] * c4[0] - v0[1] * s4[0]; o0[1] = v0[1] * c4[0] + v0[0] * s4[0];
                        o0[2] = v0[2] * c4[1] - v0[3] * s4[1]; o0[3] = v0[3] * c4[1] + v0[2] * s4[1];
                        o1[0] = v1[0] * c4[2] - v1[1] * s4[2]; o1[1] = v1[1] * c4[2] + v1[0] * s4[2];
                        o1[2] = v1[2] * c4[3] - v1[3] * s4[3]; o1[3] = v1[3] * c4[3] + v1[2] * s4[3];
                        v0 = o0 * qs; v1 = o1 * qs;
                    }
                    *(u32x4*)(H + (size_t)row * HP + col) = pack8(v0, v1);
                } }
            }
        }
    }
};
__device__ __forceinline__ void sig8(u32x4 g, f32x4& s0, f32x4& s1) {
    s0[0] = sigmoidf_(bflo(g.x)); s0[1] = sigmoidf_(bfhi(g.x)); s0[2] = sigmoidf_(bflo(g.y)); s0[3] = sigmoidf_(bfhi(g.y));
    s1[0] = sigmoidf_(bflo(g.z)); s1[1] = sigmoidf_(bfhi(g.z)); s1[2] = sigmoidf_(bflo(g.w)); s1[3] = sigmoidf_(bfhi(g.w));
}
template <int SECOND> struct EpiBranch {
    bf16_t* ACT; const bf16_t* Hg;
    __device__ __forceinline__ void operator()(const AccT& acc, const pg8::Unit& u, int wr, int wc, int fr, int fq) const {
        EPI_LOOP_BEGIN
            EPI_ROWS_BEGIN
                const u32x4 g = *(const u32x4*)(Hg + (size_t)row * HP + col);
                f32x4 s0, s1; sig8(g, s0, s1);
                v0 = v0 * s0; v1 = v1 * s1;
                bf16_t* dst = ACT + (size_t)row * DM + col;
                if (SECOND) { const u32x4 p = *(const u32x4*)dst;
                    v0[0] += bflo(p.x); v0[1] += bfhi(p.x); v0[2] += bflo(p.y); v0[3] += bfhi(p.y);
                    v1[0] += bflo(p.z); v1[1] += bfhi(p.z); v1[2] += bflo(p.w); v1[3] += bfhi(p.w); }
                *(u32x4*)dst = pack8(v0, v1);
        EPI_END
    }
};
struct EpiF32 {
    float* Y;
    __device__ __forceinline__ void operator()(const AccT& acc, const pg8::Unit& u, int wr, int wc, int fr, int fq) const {
        EPI_LOOP_BEGIN
            EPI_ROWS_BEGIN
                float* dst = Y + (size_t)row * DM + col;
                *(f32x4*)dst = v0; *(f32x4*)(dst + 4) = v1;
        EPI_END
    }
};
struct EpiRelu2 {
    bf16_t* Hd;
    __device__ __forceinline__ void operator()(const AccT& acc, const pg8::Unit& u, int wr, int wc, int fr, int fq) const {
        EPI_LOOP_BEGIN
            EPI_ROWS_BEGIN
#pragma unroll
                for (int e = 0; e < 4; ++e) { const float a = fmaxf(v0[e], 0.f), b = fmaxf(v1[e], 0.f); v0[e] = a * a; v1[e] = b * b; }
                *(u32x4*)(Hd + (size_t)row * FF + col) = pack8(v0, v1);
        EPI_END
    }
};

__device__ __forceinline__ int inproj_src(int j) {
    if (j < 512) return (j & ~63) | dmap(j & 63);
    if (j < 896) { const int seg = (j - 512) >> 7, w = (j - 512) & 127; const int base = seg == 0 ? 512 : (seg == 1 ? 768 : 1024); return base + (w & 64) + dmap(w & 63); }
    if (j < 1280) { const int seg = (j - 896) >> 7, w = (j - 896) & 127; const int base = seg == 0 ? 640 : (seg == 1 ? 896 : 1152); return base + w; }
    if (j < NIN) return j;
    return -1;
}
template <int COLMODE, int ROWMODE>
__device__ __forceinline__ void transpose_item(const float* W, int N, bf16_t* WT, int Kd, LAS float* scr, int kb, int nb, int lane) {
    const int k0 = 64 * kb, n0 = 32 * nb; const int j = n0 + (lane & 31);
    int sc = j; if (COLMODE == 1) sc = inproj_src(j); if (COLMODE == 2) sc = (j & ~63) | dmap(j & 63);
    float tv[32];
#pragma unroll
    for (int i = 0; i < 32; ++i) { const int kk = 2 * i + (lane >> 5); int sr = k0 + kk; if (ROWMODE == 1) sr = (sr & ~63) | dmap(sr & 63);
        tv[i] = sc >= 0 ? W[(size_t)sr * N + sc] : 0.f; }
#pragma unroll
    for (int i = 0; i < 32; ++i) { const int kk = 2 * i + (lane >> 5); scr[kk * 33 + (lane & 31)] = tv[i]; }
    asm volatile("s_waitcnt lgkmcnt(0)" ::: "memory");
    const int c = lane & 7;
#pragma unroll
    for (int jj = 0; jj < 4; ++jj) { const int n = (lane >> 3) + 8 * jj; const LAS float* s = scr + (8 * c) * 33 + n;
        u32x4 o; o.x = pk2(s[0 * 33], s[1 * 33]); o.y = pk2(s[2 * 33], s[3 * 33]); o.z = pk2(s[4 * 33], s[5 * 33]); o.w = pk2(s[6 * 33], s[7 * 33]);
        *(u32x4*)(WT + (size_t)(n0 + n) * Kd + k0 + 8 * c) = o; }
    asm volatile("s_waitcnt lgkmcnt(0)" ::: "memory");
}

__device__ __forceinline__ void phase_prologue(const Params& p, lptr L) {
    int tid_ = threadIdx.x; asm volatile("" : "+v"(tid_)); const int tid = tid_, lane = tid & 63, wave = __builtin_amdgcn_readfirstlane(tid >> 6);
    const int G = gridDim.x;
    unsigned char* ws = p.ws;
    for (int u = blockIdx.x; u < 224; u += G) {
        if (u < 192) {
            const int l = u / 96, cc = u % 96;
            LAS float* COND = (LAS float*)L;
            for (int i = 0; i < 64; ++i) { const int e = tid + 512 * i, b = e >> 10, k = e & 1023; const float v = p.in[1][b * 1024 + k]; COND[k * 32 + b] = v * sigmoidf_(v); }
            __syncthreads();
            const float* wp = p.in[15] + (size_t)l * 1024 * 6144 + cc * 64 + lane;
            float acc[32];
#pragma unroll
            for (int b = 0; b < 32; ++b) acc[b] = 0.f;
            for (int k8 = 0; k8 < 128; k8 += 16) { float wv16[16];
#pragma unroll
                for (int q = 0; q < 16; ++q) wv16[q] = wp[(size_t)(wave * 128 + k8 + q) * 6144];
#pragma unroll
                for (int q = 0; q < 16; ++q) { const int k = wave * 128 + k8 + q; const float wv = wv16[q];
#pragma unroll
                    for (int b4 = 0; b4 < 8; ++b4) { const f32x4 c4 = *(const LAS f32x4*)(COND + k * 32 + 4 * b4);
                        acc[4 * b4 + 0] += c4[0] * wv; acc[4 * b4 + 1] += c4[1] * wv; acc[4 * b4 + 2] += c4[2] * wv; acc[4 * b4 + 3] += c4[3] * wv; } } }
            __syncthreads();
            LAS float* RED = (LAS float*)L;
#pragma unroll
            for (int b = 0; b < 32; ++b) RED[(wave * 32 + b) * 64 + lane] = acc[b];
            __syncthreads();
            float* mod = (float*)(ws + WS_MOD) + (size_t)l * 32 * 6144;
            for (int i = 0; i < 4; ++i) { const int e = tid + 512 * i, b = e >> 6, cl = e & 63; float s = 0.f;
#pragma unroll
                for (int w = 0; w < 8; ++w) s += RED[(w * 32 + b) * 64 + cl];
                mod[(size_t)b * 6144 + cc * 64 + cl] = s + p.in[16][l * 6144 + cc * 64 + cl]; }
            __syncthreads();
        } else {
            const int lk = (u - 192) >> 3, sl = (u - 192) & 7, l = lk >> 1, kv = lk & 1;
            const float* pe = p.in[kv ? 5 : 4] + l * 2048; const float* w1 = p.in[kv ? 8 : 6] + (size_t)l * 2048 * 128;
            const int ks = tid >> 7, n = tid & 127; float s = 0.f; const int kb0 = sl * 256 + ks * 64;
#pragma unroll
            for (int k4 = 0; k4 < 64; k4 += 16) { float wv16[16];
#pragma unroll
                for (int q = 0; q < 16; ++q) wv16[q] = w1[(size_t)(kb0 + k4 + q) * 128 + n];
#pragma unroll
                for (int q = 0; q < 16; ++q) s += pe[kb0 + k4 + q] * wv16[q]; }
            LAS float* RED = (LAS float*)L; RED[ks * 128 + n] = s;
            __syncthreads();
            if (tid < 128) ((float*)(ws + WS_C1))[(lk * 8 + sl) * 128 + tid] = (RED[tid] + RED[128 + tid]) + (RED[256 + tid] + RED[384 + tid]);
            __syncthreads();
        }
    }
    const int gt = blockIdx.x * 512 + tid, NGT = G * 512;
    for (int e = gt; e < SEQ * 32; e += NGT) { const int pos = e >> 5, i = e & 31;
        const float inv = 1.0f / powf(10000.0f, (float)(2 * i) / 64.0f); const float ang = (float)pos * inv;
        const double rev = (double)ang * 0.15915494309189535; const float fr = (float)(rev - floor(rev));
        ((float*)(ws + WS_COS))[e] = __builtin_amdgcn_cosf(fr); ((float*)(ws + WS_SIN))[e] = __builtin_amdgcn_sinf(fr); }
    for (int e = gt; e < 2 * NINP; e += NGT) { const int l = e / NINP, j = e % NINP; const int s = inproj_src(j); ((float*)(ws + WS_BIAS))[e] = s >= 0 ? p.in[3][l * NIN + s] : 0.f; }
    LAS float* scr = (LAS float*)(L + wave * 8448);
    const int gw = blockIdx.x * 8 + wave, NGW = G * 8;
    for (int it = gw; it < 16400; it += NGW) {
        int r = it;
        if (r < 5632) { const int l = r / 2816, q = r % 2816; transpose_item<1, 0>(p.in[2] + (size_t)l * 1024 * NIN, NIN, (bf16_t*)(ws + WS_WIN) + (size_t)l * NINP * 1024, 1024, scr, q / 176, q % 176, lane); continue; } r -= 5632;
        if (r < 512) { const int l = r / 256, q = r % 256; transpose_item<0, 0>(p.in[12] + (size_t)l * 512 * 1024, 1024, (bf16_t*)(ws + WS_WBA) + (size_t)l * 1024 * 512, 512, scr, q / 32, q % 32, lane); continue; } r -= 512;
        if (r < 512) { const int l = r / 256, q = r % 256; transpose_item<0, 0>(p.in[13] + (size_t)l * 512 * 1024, 1024, (bf16_t*)(ws + WS_WBB) + (size_t)l * 1024 * 512, 512, scr, q / 32, q % 32, lane); continue; } r -= 512;
        if (r < 1024) { const int l = r / 512, q = r % 512; transpose_item<0, 0>(p.in[14] + (size_t)l * 1024 * 1024, 1024, (bf16_t*)(ws + WS_WOUT) + (size_t)l * 1024 * 1024, 1024, scr, q / 32, q % 32, lane); continue; } r -= 1024;
        if (r < 4096) { const int l = r / 2048, q = r % 2048; transpose_item<0, 0>(p.in[19] + (size_t)l * 1024 * 4096, 4096, (bf16_t*)(ws + WS_W1) + (size_t)l * 4096 * 1024, 1024, scr, q / 128, q % 128, lane); continue; } r -= 4096;
        if (r < 4096) { const int l = r / 2048, q = r % 2048; transpose_item<0, 0>(p.in[20] + (size_t)l * 4096 * 1024, 1024, (bf16_t*)(ws + WS_W2) + (size_t)l * 1024 * 4096, 4096, scr, q / 32, q % 32, lane); continue; } r -= 4096;
        if (r < 256) { const int l = r / 128, q = r % 128; transpose_item<0, 1>(p.in[6] + (size_t)l * 2048 * 128, 128, (bf16_t*)(ws + WS_CW1) + (size_t)(l * 2 + 0) * 128 * 2048, 2048, scr, q / 4, q % 4, lane); continue; } r -= 256;
        if (r < 256) { const int l = r / 128, q = r % 128; transpose_item<0, 0>(p.in[8] + (size_t)l * 2048 * 128, 128, (bf16_t*)(ws + WS_CW1) + (size_t)(l * 2 + 1) * 128 * 2048, 2048, scr, q / 4, q % 4, lane); continue; } r -= 256;
        if (r < 8) { const int l = r / 4, q = r % 4; transpose_item<2, 0>(p.in[7] + (size_t)l * 128 * 64, 64, (bf16_t*)(ws + WS_CW2) + (size_t)(l * 2 + 0) * 64 * 128, 128, scr, q / 2, q % 2, lane); continue; } r -= 8;
        { const int l = r / 4, q = r % 4; transpose_item<0, 0>(p.in[9] + (size_t)l * 128 * 64, 64, (bf16_t*)(ws + WS_CW2) + (size_t)(l * 2 + 1) * 64 * 128, 128, scr, q / 2, q % 2, lane); }
    }
}

__device__ __forceinline__ void phase_modulate(const Params& p, const float* x, int l) {
    int tid_ = threadIdx.x; asm volatile("" : "+v"(tid_)); const int tid = tid_, lane = tid & 63, wave = tid >> 6; const int gw = blockIdx.x * 8 + wave, NGW = gridDim.x * 8;
    const float* mod = (const float*)(p.ws + WS_MOD) + (size_t)l * 32 * 6144; bf16_t* ACT = (bf16_t*)(p.ws + WS_ACT);
    for (int row = gw; row < NT; row += NGW) { const int b = row >> 11; const float* sh = mod + (size_t)b * 6144; const float* sc = sh + 1024;
#pragma unroll
        for (int j = 0; j < 4; ++j) { const int c = 4 * lane + 256 * j; const f32x4 v = *(const f32x4*)(x + (size_t)row * DM + c), a = *(const f32x4*)(sc + c), d = *(const f32x4*)(sh + c);
            const f32x4 o = v * (a + 1.0f) + d; u32x2 w; w.x = pk2(o[0], o[1]); w.y = pk2(o[2], o[3]); *(u32x2*)(ACT + (size_t)row * DM + c) = w; } }
}
__device__ __forceinline__ void phase_ln(const Params& p, const float* xin, const float* Y, float* xout, const float* gtv  ,
                                         const float* gam, const float* bet, const float* nsh  , const float* nsc) {
    int tid_ = threadIdx.x; asm volatile("" : "+v"(tid_)); const int tid = tid_, lane = tid & 63, wave = tid >> 6; const int gw = blockIdx.x * 8 + wave, NGW = gridDim.x * 8;
    bf16_t* ACT = (bf16_t*)(p.ws + WS_ACT);
    for (int row = gw; row < NT; row += NGW) { const int b = row >> 11; f32x4 v[4]; float s = 0.f;
#pragma unroll
        for (int j = 0; j < 4; ++j) { const int c = 4 * lane + 256 * j; const f32x4 xv = *(const f32x4*)(xin + (size_t)row * DM + c), yv = *(const f32x4*)(Y + (size_t)row * DM + c), gv = *(const f32x4*)(gtv + (size_t)b * 6144 + c);
            v[j] = xv * DN_ALPHA + (gv + 1.0f) * yv; s += (v[j][0] + v[j][1]) + (v[j][2] + v[j][3]); }
        const float mean = wave_sum(s) * (1.f / DM); float s2 = 0.f;
#pragma unroll
        for (int j = 0; j < 4; ++j) { v[j] = v[j] - mean; s2 += (v[j][0] * v[j][0] + v[j][1] * v[j][1]) + (v[j][2] * v[j][2] + v[j][3] * v[j][3]); }
        const float rstd = 1.0f / sqrtf(wave_sum(s2) * (1.f / DM) + LN_EPS);
#pragma unroll
        for (int j = 0; j < 4; ++j) { const int c = 4 * lane + 256 * j; const f32x4 o = v[j] * rstd * *(const f32x4*)(gam + c) + *(const f32x4*)(bet + c);
            *(f32x4*)(xout + (size_t)row * DM + c) = o;
            if (nsh) { const f32x4 a = *(const f32x4*)(nsc + (size_t)b * 6144 + c), d = *(const f32x4*)(nsh + (size_t)b * 6144 + c); const f32x4 q = o * (a + 1.0f) + d;
                u32x2 w; w.x = pk2(q[0], q[1]); w.y = pk2(q[2], q[3]); *(u32x2*)(ACT + (size_t)row * DM + c) = w; } } }
}

__device__ __forceinline__ void compress_unit(const Params& p, int l, int unit, lptr L) {
    int tid_ = threadIdx.x; asm volatile("" : "+v"(tid_)); const int tid = tid_, lane = tid & 63, w = __builtin_amdgcn_readfirstlane(tid >> 6), i = lane & 31, hi = lane >> 5;
    const int bg = unit >> 1, kv = unit & 1, b = bg >> 1, g = bg & 1;
    const bf16_t* H = (const bf16_t*)(p.ws + WS_H);
    const bf16_t* src = H + (size_t)b * SEQ * HP + (kv ? C_VC : C_KC) + g * 64;
    const bf16_t* W1t = (const bf16_t*)(p.ws + WS_CW1) + (size_t)(l * 2 + kv) * 128 * 2048;
    const bf16_t* W2t = (const bf16_t*)(p.ws + WS_CW2) + (size_t)(l * 2 + kv) * 64 * 128;
    const float* c1p = (const float*)(p.ws + WS_C1) + (l * 2 + kv) * 8 * 128;
    const int mt = w & 3, nh = w >> 2;
    int nrow = 32 * mt + i; if (nrow > 126) nrow = 126;
    const bf16_t* arow = src + (size_t)(16 * nrow) * HP + 8 * hi;
    const bf16_t* b0row = W1t + (size_t)(64 * nh + i) * 2048 + 8 * hi;
    const bf16_t* b1row = b0row + 32 * 2048;
    f32x16 acc0 = zero16(), acc1 = zero16();
#pragma unroll 4
    for (int ks = 0; ks < 128; ++ks) { const int pp = ks >> 2, dc = ks & 3;
        const bf16x8 a = *(const bf16x8*)(arow + (size_t)pp * HP + dc * 16);
        const bf16x8 b0 = *(const bf16x8*)(b0row + ks * 16), b1 = *(const bf16x8*)(b1row + ks * 16);
        acc0 = mfma32(a, b0, acc0); acc1 = mfma32(a, b1, acc1); }
    LAS bf16_t* Hh = (LAS bf16_t*)L;
    { float cb0 = 0.f, cb1 = 0.f;
#pragma unroll
      for (int sl = 0; sl < 8; ++sl) { cb0 += c1p[sl * 128 + 64 * nh + i]; cb1 += c1p[sl * 128 + 64 * nh + 32 + i]; }
#pragma unroll
      for (int r = 0; r < 16; ++r) { const int row = 32 * mt + crow(r, hi); float x0 = acc0[r] + cb0, x1 = acc1[r] + cb1; x0 = x0 * sigmoidf_(x0); x1 = x1 * sigmoidf_(x1);
          Hh[row * 136 + 64 * nh + i] = (bf16_t)f2bf(x0); Hh[row * 136 + 64 * nh + 32 + i] = (bf16_t)f2bf(x1); } }
    __syncthreads();
    { const int mt2 = w & 3, nt2 = w >> 2; f32x16 acc = zero16();
#pragma unroll
      for (int ks = 0; ks < 8; ++ks) { const bf16x8 a = *(const LAS bf16x8*)(Hh + (32 * mt2 + i) * 136 + 16 * ks + 8 * hi);
          const bf16x8 bb = *(const bf16x8*)(W2t + (size_t)(32 * nt2 + i) * 128 + 16 * ks + 8 * hi); acc = mfma32(a, bb, acc); }
      bf16_t* out = (bf16_t*)(p.ws + WS_KCC) + (size_t)(kv * 64 + bg) * 128 * 64;
#pragma unroll
      for (int r = 0; r < 16; ++r) out[(32 * mt2 + crow(r, hi)) * 64 + 32 * nt2 + i] = (bf16_t)f2bf(acc[r]); }
    __syncthreads();
}

constexpr int HG_LF = 0, HG_TOT = 32768, HG_DEC = 34816, HG_QT = 35328, HG_KH = 52736, HG_KHT = 70144, HG_VT = 88576, HG_ST = 97792, HG_AM = 115200, HG_OF = 124416;
__device__ __forceinline__ void hgrn_unit(const Params& p, int l, int unit, lptr L) {
    int tid_ = threadIdx.x; asm volatile("" : "+v"(tid_)); const int tid = tid_, lane = tid & 63, w = __builtin_amdgcn_readfirstlane(tid >> 6), i = lane & 31, hi = lane >> 5;
    const int b = unit >> 3, hh = (unit >> 1) & 3, half = unit & 1;
    bf16_t* H = (bf16_t*)(p.ws + WS_H);
    const int t = tid >> 3, ds = tid & 7, d0 = ds * 16;
    LAS float* LF = (LAS float*)(L + HG_LF); LAS float* TOT = (LAS float*)(L + HG_TOT); LAS float* DEC = (LAS float*)(L + HG_DEC);
    LAS bf16_t* QT = (LAS bf16_t*)(L + HG_QT); LAS bf16_t* KH = (LAS bf16_t*)(L + HG_KH); LAS bf16_t* KHT = (LAS bf16_t*)(L + HG_KHT);
    LAS bf16_t* VT = (LAS bf16_t*)(L + HG_VT); LAS bf16_t* ST = (LAS bf16_t*)(L + HG_ST); LAS bf16_t* AM = (LAS bf16_t*)(L + HG_AM); LAS float* OF = (LAS float*)(L + HG_OF);
    float lbv[16];
#pragma unroll
    for (int e = 0; e < 16; ++e) { const int c = hh * 128 + d0 + e; lbv[e] = l == 0 ? 0.f : 1.0f / (1.0f + fexp(p.in[10][c] - p.in[10][512 + c])); }
    const int dkt = w & 3, dvt = w >> 2;
    f32x16 sacc = zero16();
    u32x4 nq0, nq1, nf0, nf1, nvv;
    { const size_t ro = (size_t)(b * SEQ + t) * HP;
      nq0 = *(const u32x4*)(H + ro + C_QB + hh * 128 + d0); nq1 = *(const u32x4*)(H + ro + C_QB + hh * 128 + d0 + 8);
      nf0 = *(const u32x4*)(H + ro + C_FB + hh * 128 + d0); nf1 = *(const u32x4*)(H + ro + C_FB + hh * 128 + d0 + 8);
      nvv = *(const u32x4*)(H + ro + C_IB + hh * 128 + half * 64 + ds * 8); }
    for (int c = 0; c < 32; ++c) {
        const size_t rowoff = (size_t)(b * SEQ + 64 * c + t) * HP;
        float qs[16], kk[16];
        {
            const u32x4 q0 = nq0, q1 = nq1, f0 = nf0, f1 = nf1, vv = nvv;
            if (c < 31) { const size_t ro = rowoff + (size_t)64 * HP;
                nq0 = *(const u32x4*)(H + ro + C_QB + hh * 128 + d0); nq1 = *(const u32x4*)(H + ro + C_QB + hh * 128 + d0 + 8);
                nf0 = *(const u32x4*)(H + ro + C_FB + hh * 128 + d0); nf1 = *(const u32x4*)(H + ro + C_FB + hh * 128 + d0 + 8);
                nvv = *(const u32x4*)(H + ro + C_IB + hh * 128 + half * 64 + ds * 8); }
            float zq[16], zf[16];
            zq[0] = bflo(q0.x); zq[1] = bfhi(q0.x); zq[2] = bflo(q0.y); zq[3] = bfhi(q0.y); zq[4] = bflo(q0.z); zq[5] = bfhi(q0.z); zq[6] = bflo(q0.w); zq[7] = bfhi(q0.w);
            zq[8] = bflo(q1.x); zq[9] = bfhi(q1.x); zq[10] = bflo(q1.y); zq[11] = bfhi(q1.y); zq[12] = bflo(q1.z); zq[13] = bfhi(q1.z); zq[14] = bflo(q1.w); zq[15] = bfhi(q1.w);
            zf[0] = bflo(f0.x); zf[1] = bfhi(f0.x); zf[2] = bflo(f0.y); zf[3] = bfhi(f0.y); zf[4] = bflo(f0.z); zf[5] = bfhi(f0.z); zf[6] = bflo(f0.w); zf[7] = bfhi(f0.w);
            zf[8] = bflo(f1.x); zf[9] = bfhi(f1.x); zf[10] = bflo(f1.y); zf[11] = bfhi(f1.y); zf[12] = bflo(f1.z); zf[13] = bfhi(f1.z); zf[14] = bflo(f1.w); zf[15] = bfhi(f1.w);
            float lf[16];
#pragma unroll
            for (int e = 0; e < 16; ++e) { qs[e] = zq[e] * sigmoidf_(zq[e]) * 0.08838834764831845f; const float f = lbv[e] + (1.0f - lbv[e]) * sigmoidf_(zf[e]); lf[e] = __logf(f); kk[e] = 1.0f - f; }
#pragma unroll
            for (int e4 = 0; e4 < 4; ++e4) *(LAS f32x4*)(LF + t * 128 + d0 + 4 * e4) = (f32x4){lf[4 * e4], lf[4 * e4 + 1], lf[4 * e4 + 2], lf[4 * e4 + 3]};
            const int dv0 = ds * 8;
            VT[(dv0 + 0) * 72 + t] = (bf16_t)(vv.x & 0xffff); VT[(dv0 + 1) * 72 + t] = (bf16_t)(vv.x >> 16); VT[(dv0 + 2) * 72 + t] = (bf16_t)(vv.y & 0xffff); VT[(dv0 + 3) * 72 + t] = (bf16_t)(vv.y >> 16);
            VT[(dv0 + 4) * 72 + t] = (bf16_t)(vv.z & 0xffff); VT[(dv0 + 5) * 72 + t] = (bf16_t)(vv.z >> 16); VT[(dv0 + 6) * 72 + t] = (bf16_t)(vv.w & 0xffff); VT[(dv0 + 7) * 72 + t] = (bf16_t)(vv.w >> 16);
        }
        LDS_BARRIER();
        {
            const int d = tid & 127, seg = tid >> 7; float run = 0.f;
#pragma unroll
            for (int tt = 0; tt < 16; ++tt) { run += LF[(16 * seg + tt) * 128 + d]; LF[(16 * seg + tt) * 128 + d] = run; }
            TOT[seg * 128 + d] = run;
        }
        LDS_BARRIER();
        {
            const int seg = t >> 4;
#pragma unroll
            for (int e4 = 0; e4 < 4; ++e4) {
                const f32x4 lfv = *(const LAS f32x4*)(LF + t * 128 + d0 + 4 * e4);
                const f32x4 t0 = *(const LAS f32x4*)(TOT + d0 + 4 * e4), t1 = *(const LAS f32x4*)(TOT + 128 + d0 + 4 * e4), t2 = *(const LAS f32x4*)(TOT + 256 + d0 + 4 * e4), t3 = *(const LAS f32x4*)(TOT + 384 + d0 + 4 * e4);
                f32x4 pre = (f32x4){0.f, 0.f, 0.f, 0.f}; if (seg > 0) pre = pre + t0; if (seg > 1) pre = pre + t1; if (seg > 2) pre = pre + t2;
                const f32x4 bt = lfv + pre, bl = (t0 + t1) + (t2 + t3);
                unsigned qw[4], kw[4];
#pragma unroll
                for (int e = 0; e < 4; ++e) { const float dq = fminf(bt[e] - bl[e], 80.f); const float qv = qs[4 * e4 + e] * fexp(dq), kvv = kk[4 * e4 + e] * fexp(bl[e] - bt[e]);
                    qw[e] = f2bf(qv); kw[e] = f2bf(kvv); KHT[(d0 + 4 * e4 + e) * 72 + t] = (bf16_t)kw[e];
                    if (t == 0) DEC[d0 + 4 * e4 + e] = fexp(bl[e]); }
                *(LAS u32x2*)(QT + t * 136 + d0 + 4 * e4) = (u32x2){qw[0] | (qw[1] << 16), qw[2] | (qw[3] << 16)};
                *(LAS u32x2*)(KH + t * 136 + d0 + 4 * e4) = (u32x2){kw[0] | (kw[1] << 16), kw[2] | (kw[3] << 16)};
            }
        }
        LDS_BARRIER();
        {
#pragma unroll
            for (int r = 0; r < 16; ++r) sacc[r] *= DEC[32 * dkt + crow(r, hi)];
#pragma unroll
            for (int m = 0; m < 4; ++m) *(LAS u32x2*)(ST + (32 * dvt + i) * 136 + 32 * dkt + 8 * m + 4 * hi) = (u32x2){pk2(sacc[4 * m], sacc[4 * m + 1]), pk2(sacc[4 * m + 2], sacc[4 * m + 3])};
            if (w >= 4 && w < 7) { const int tm = (w - 4) == 0 ? 0 : 1, tn = (w - 4) == 2 ? 1 : 0; f32x16 am = zero16();
#pragma unroll
                for (int ks = 0; ks < 8; ++ks) { const bf16x8 a = *(const LAS bf16x8*)(QT + (32 * tm + i) * 136 + 16 * ks + 8 * hi), bb = *(const LAS bf16x8*)(KH + (32 * tn + i) * 136 + 16 * ks + 8 * hi); am = mfma32(a, bb, am); }
#pragma unroll
                for (int r = 0; r < 16; ++r) { const int tt = 32 * tm + crow(r, hi), ss = 32 * tn + i; AM[tt * 72 + ss] = (bf16_t)f2bf(ss <= tt ? am[r] : 0.f); } }
        }
        LDS_BARRIER();
        {
            if (w < 4) { const int mt = w & 1, nt = w >> 1; f32x16 o = zero16();
#pragma unroll
                for (int ks = 0; ks < 8; ++ks) { const bf16x8 a = *(const LAS bf16x8*)(QT + (32 * mt + i) * 136 + 16 * ks + 8 * hi), bb = *(const LAS bf16x8*)(ST + (32 * nt + i) * 136 + 16 * ks + 8 * hi); o = mfma32(a, bb, o); }
#pragma unroll
                for (int ks = 0; ks < 4; ++ks) if (ks < 2 || mt == 1) { const bf16x8 a = *(const LAS bf16x8*)(AM + (32 * mt + i) * 72 + 16 * ks + 8 * hi), bb = *(const LAS bf16x8*)(VT + (32 * nt + i) * 72 + 16 * ks + 8 * hi); o = mfma32(a, bb, o); }
#pragma unroll
                for (int r = 0; r < 16; ++r) OF[(32 * mt + crow(r, hi)) * 64 + 32 * nt + i] = o[r]; }
#pragma unroll
            for (int ks = 0; ks < 4; ++ks) { const bf16x8 a = *(const LAS bf16x8*)(KHT + (32 * dkt + i) * 72 + 16 * ks + 8 * hi), bb = *(const LAS bf16x8*)(VT + (32 * dvt + i) * 72 + 16 * ks + 8 * hi); sacc = mfma32(a, bb, sacc); }
        }
        LDS_BARRIER();
        {
            const f32x4 o0 = *(const LAS f32x4*)(OF + t * 64 + ds * 8), o1 = *(const LAS f32x4*)(OF + t * 64 + ds * 8 + 4);
            *(u32x4*)(H + rowoff + C_IB + hh * 128 + half * 64 + ds * 8) = pack8(o0, o1);
        }
    }
    __syncthreads();
}
__device__ __forceinline__ void hgrn_norm_rows(const Params& p, int l) {
    int tid_ = threadIdx.x; asm volatile("" : "+v"(tid_)); const int tid = tid_, lane = tid & 63, wave = tid >> 6; const int gw = blockIdx.x * 8 + wave, NGW = gridDim.x * 8;
    bf16_t* H = (bf16_t*)(p.ws + WS_H); const float* ng = p.in[11] + l * 128 + (lane & 15) * 8;
    const f32x4 n0 = *(const f32x4*)ng, n1 = *(const f32x4*)(ng + 4);
    for (int row = gw; row < NT; row += NGW) {
        bf16_t* op = H + (size_t)row * HP + C_IB + lane * 8; const u32x4 ov = *(const u32x4*)op, gv = *(const u32x4*)(H + (size_t)row * HP + C_GB + lane * 8);
        float o[8] = {bflo(ov.x), bfhi(ov.x), bflo(ov.y), bfhi(ov.y), bflo(ov.z), bfhi(ov.z), bflo(ov.w), bfhi(ov.w)};
        float gg[8] = {bflo(gv.x), bfhi(gv.x), bflo(gv.y), bfhi(gv.y), bflo(gv.z), bfhi(gv.z), bflo(gv.w), bfhi(gv.w)};
        float ss = 0.f;
#pragma unroll
        for (int e = 0; e < 8; ++e) ss += o[e] * o[e];
        ss += __shfl_xor(ss, 1); ss += __shfl_xor(ss, 2); ss += __shfl_xor(ss, 4); ss += __shfl_xor(ss, 8);
        const float rs = 1.0f / sqrtf(ss * (1.0f / 128.0f) + RMS_EPS);
        f32x4 r0, r1;
#pragma unroll
        for (int e = 0; e < 4; ++e) { r0[e] = o[e] * rs * n0[e] * (gg[e] * sigmoidf_(gg[e])); r1[e] = o[4 + e] * rs * n1[e] * (gg[4 + e] * sigmoidf_(gg[4 + e])); }
        *(u32x4*)op = pack8(r0, r1);
    }
}

constexpr int AT_K = 0, AT_V = 18432, AT_IMP = 36864, AT_SEL = 69632, AT_WSF = 69888, AT_YL = 71680, AT_PITCH = 144;
struct TileRegs { u32x4 k, v; };
__device__ __forceinline__ TileRegs attn_load_tile(const bf16_t* kbase, const bf16_t* vbase, int tile, int tid) {
    TileRegs r; const size_t off = (size_t)(64 * tile + (tid >> 3)) * HP + (tid & 7) * 8; r.k = *(const u32x4*)(kbase + off); r.v = *(const u32x4*)(vbase + off); return r;
}
__device__ __forceinline__ void attn_store_tile(lptr L, const TileRegs& r, int tid, int buf) {
    const int o = buf * 9216 + (tid >> 3) * AT_PITCH + (tid & 7) * 16; *(LAS u32x4*)(L + AT_K + o) = r.k; *(LAS u32x4*)(L + AT_V + o) = r.v;
}
__device__ __forceinline__ void attn_qk(lptr L, int krow0, const bf16x8 (&qr)[4], f32x16& p0, f32x16& p1, int i, int hi) {
    const lptr kb = L + AT_K + (krow0 + i) * AT_PITCH + hi * 16; p0 = zero16(); p1 = zero16();
#pragma unroll
    for (int ks = 0; ks < 4; ++ks) { const bf16x8 k0 = *(const LAS bf16x8*)(kb + ks * 32), k1 = *(const LAS bf16x8*)(kb + 32 * AT_PITCH + ks * 32);
        p0 = mfma32(k0, qr[ks], p0); p1 = mfma32(k1, qr[ks], p1); }
}
__device__ __forceinline__ bf16x8 pack_p(const f32x16& p, int base) {
    u32x4 w; w.x = pk2(p[base], p[base + 1]); w.y = pk2(p[base + 2], p[base + 3]); w.z = pk2(p[base + 4], p[base + 5]); w.w = pk2(p[base + 6], p[base + 7]); return __builtin_bit_cast(bf16x8, w);
}
__device__ __forceinline__ void attn_pv16(lptr L, int vrow0, bf16x8 pa, f32x16 (&o)[2], int lane) {
    const int hi = lane >> 5;
    const lptr vb = L + AT_V + (vrow0 + 4 * hi + ((lane & 15) >> 2)) * AT_PITCH + ((lane >> 4) & 1) * 32 + (lane & 3) * 8;
#pragma unroll
    for (int d0 = 0; d0 < 2; ++d0) {
        const s16x4 lo = __builtin_bit_cast(s16x4, __builtin_amdgcn_ds_read_tr16_b64_v4i16((LAS s16x4*)(vb + d0 * 64)));
        const s16x4 up = __builtin_bit_cast(s16x4, __builtin_amdgcn_ds_read_tr16_b64_v4i16((LAS s16x4*)(vb + 8 * AT_PITCH + d0 * 64)));
        const bf16x8 bb = (bf16x8){lo[0], lo[1], lo[2], lo[3], up[0], up[1], up[2], up[3]};
        o[d0] = mfma32(pa, bb, o[d0]);
    }
}
struct SoftState { float m, l; f32x16 o[2]; };
template <int MODE>
__device__ __forceinline__ void attn_tile_step(lptr L, int buf, const bf16x8 (&qr)[4], SoftState& st, bool allowed, int tq, LAS float* wsf, int lane) {
    const int i = lane & 31, hi = lane >> 5; const float NEG = -__builtin_inff();
    f32x16 p0, p1; attn_qk(L, buf * 64, qr, p0, p1, i, hi);
    if (MODE != 0) {
#pragma unroll
        for (int r = 0; r < 16; ++r) { const int k0 = crow(r, hi), k1 = k0 + 32;
            if (MODE == 1) { p0[r] = (k0 <= tq) ? p0[r] : NEG; p1[r] = (k1 <= tq) ? p1[r] : NEG; }
            if (MODE == 2) { p0[r] = (k0 > tq) ? p0[r] : NEG; p1[r] = (k1 > tq) ? p1[r] : NEG; } }
    }
    float mx = fmaxf(p0[0], p1[0]);
#pragma unroll
    for (int r = 1; r < 16; ++r) mx = fmaxf(mx, fmaxf(p0[r], p1[r]));
    mx = fmaxf(mx, __shfl_xor(mx, 32));
    if (!allowed) mx = NEG;
    const bool need = mx > st.m + 8.0f;
    if (__any(need)) {
        const float mnew = need ? mx : st.m;
        const float alpha = need ? __builtin_amdgcn_exp2f(st.m - mnew) : 1.0f;
        st.l *= alpha; st.m = mnew;
        if (hi == 0) wsf[i] = alpha;
        asm volatile("s_waitcnt lgkmcnt(0)" ::: "memory");
#pragma unroll
        for (int r = 0; r < 16; ++r) { const float a = wsf[crow(r, hi)]; st.o[0][r] *= a; st.o[1][r] *= a; }
    }
    const float sub = (allowed && st.m != NEG) ? st.m : __builtin_inff();
    float rs = 0.f;
#pragma unroll
    for (int r = 0; r < 16; ++r) { p0[r] = __builtin_amdgcn_exp2f(p0[r] - sub); p1[r] = __builtin_amdgcn_exp2f(p1[r] - sub); rs += p0[r] + p1[r]; }
    rs += __shfl_xor(rs, 32);
    st.l += rs;
    const int vr = buf * 64;
    attn_pv16(L, vr, pack_p(p0, 0), st.o, lane); attn_pv16(L, vr + 16, pack_p(p0, 8), st.o, lane);
    attn_pv16(L, vr + 32, pack_p(p1, 0), st.o, lane); attn_pv16(L, vr + 48, pack_p(p1, 8), st.o, lane);
}
template <int WHICH>
__device__ __forceinline__ void attn_finish_branch(SoftState& st, float gate, LAS float* yl, LAS float* wsf, int lane) {
    const int i = lane & 31, hi = lane >> 5;
    if (hi == 0) wsf[i] = gate / fmaxf(st.l, 1e-30f);
    asm volatile("s_waitcnt lgkmcnt(0)" ::: "memory");
#pragma unroll
    for (int r = 0; r < 16; ++r) { const float a = wsf[crow(r, hi)];
        float y0 = st.o[0][r] * a, y1 = st.o[1][r] * a;
        if (WHICH != 0) { y0 += yl[r * 64]; y1 += yl[(16 + r) * 64]; }
        if (WHICH != 2) { yl[r * 64] = y0; yl[(16 + r) * 64] = y1; } else { st.o[0][r] = y0; st.o[1][r] = y1; } }
}

__device__ __forceinline__ void attn_unit(const Params& p, int bg, int qb, lptr L) {
    int tid_ = threadIdx.x; asm volatile("" : "+v"(tid_)); const int tid = tid_, lane = tid & 63, w = __builtin_amdgcn_readfirstlane(tid >> 6), i = lane & 31, hi = lane >> 5;
    const int b = bg >> 1, g = bg & 1, rh = w >> 1, tq = 32 * (w & 1) + i;
    bf16_t* H = (bf16_t*)(p.ws + WS_H);
    const size_t seqbase = (size_t)b * SEQ * HP;
    bf16_t* qrow = H + seqbase + (size_t)(64 * qb + tq) * HP;
    LAS float* wsf = (LAS float*)(L + AT_WSF) + w * 32;
    LAS float* IMP = (LAS float*)(L + AT_IMP);
    LAS unsigned* SELM = (LAS unsigned*)(L + AT_SEL);
    { const bf16_t* kc = (const bf16_t*)(p.ws + WS_KCC) + (size_t)bg * 128 * 64; const bf16_t* vc = kc + (size_t)64 * 128 * 64;
#pragma unroll
      for (int h2 = 0; h2 < 2; ++h2) { const int row = (tid >> 3) + 64 * h2, o = row * AT_PITCH + (tid & 7) * 16;
          *(LAS u32x4*)(L + AT_K + o) = *(const u32x4*)(kc + row * 64 + (tid & 7) * 8); *(LAS u32x4*)(L + AT_V + o) = *(const u32x4*)(vc + row * 64 + (tid & 7) * 8); } }
    bf16x8 qr[4];
#pragma unroll
    for (int ks = 0; ks < 4; ++ks) qr[ks] = *(const bf16x8*)(qrow + C_QA + (g * 4 + rh) * 64 + 16 * ks + 8 * hi);
    const bf16_t* gatep = qrow + C_GATE + (g * 4 + rh) * 3;
    LAS float* yl = (LAS float*)(L + AT_YL) + w * 2048 + lane;
    const float NEG = -__builtin_inff();
    __syncthreads();
    {
        f32x16 pc[4];
        attn_qk(L, 0, qr, pc[0], pc[1], i, hi); attn_qk(L, 64, qr, pc[2], pc[3], i, hi);
        const int tpos = 64 * qb + tq; float mx = NEG;
#pragma unroll
        for (int kt = 0; kt < 4; ++kt)
#pragma unroll
            for (int r = 0; r < 16; ++r) { const int n = 32 * kt + crow(r, hi); pc[kt][r] = (16 * n + 31 <= tpos) ? pc[kt][r] : NEG; mx = fmaxf(mx, pc[kt][r]); }
        mx = fmaxf(mx, __shfl_xor(mx, 32)); const float muse = (mx == NEG) ? 0.f : mx; float rs = 0.f;
#pragma unroll
        for (int kt = 0; kt < 4; ++kt)
#pragma unroll
            for (int r = 0; r < 16; ++r) { pc[kt][r] = __builtin_amdgcn_exp2f(pc[kt][r] - muse); rs += pc[kt][r]; }
        rs += __shfl_xor(rs, 32); const float inv = 1.0f / fmaxf(rs, 1e-30f);
        float prev = 0.f;
#pragma unroll
        for (int kt = 0; kt < 4; ++kt) {
#pragma unroll
            for (int r = 0; r < 16; ++r) pc[kt][r] *= inv;
#pragma unroll
            for (int m = 0; m < 4; ++m) { const float G4 = (pc[kt][4 * m] + pc[kt][4 * m + 1]) + (pc[kt][4 * m + 2] + pc[kt][4 * m + 3]); const float yy = __shfl_xor(pc[kt][4 * m + 3], 32);
                const float val = hi ? (G4 + yy) : (G4 + prev); prev = yy; IMP[(rh * 64 + tq) * 32 + 8 * kt + 2 * m + hi] = val; } }
        SoftState sc; sc.m = 0.f; sc.l = 1.f; sc.o[0] = zero16(); sc.o[1] = zero16();
#pragma unroll
        for (int kt = 0; kt < 4; ++kt) { attn_pv16(L, 32 * kt, pack_p(pc[kt], 0), sc.o, lane); attn_pv16(L, 32 * kt + 16, pack_p(pc[kt], 8), sc.o, lane); }
        attn_finish_branch<0>(sc, sigmoidf_(bf2f(gatep[0])), yl, wsf, lane);
    }
    __syncthreads();
    if (tid < 64) {
        float sc[32];
#pragma unroll
        for (int j = 0; j < 32; ++j) { if ((j & 7) == 0) asm volatile("" ::: "memory"); const float s = (IMP[(0 * 64 + tid) * 32 + j] + IMP[(1 * 64 + tid) * 32 + j]) + (IMP[(2 * 64 + tid) * 32 + j] + IMP[(3 * 64 + tid) * 32 + j]);
            const bool valid = j <= qb, forced = valid && (j == 0 || j == qb || j == qb - 1); sc[j] = forced ? 1.0e4f : (valid ? s : -1.0f); }
        unsigned mask = 0u;
#pragma unroll
        for (int it = 0; it < 8; ++it) { float best = -3.0e38f; int bi = 0;
#pragma unroll
            for (int j = 0; j < 32; ++j) { const float v = ((mask >> j) & 1u) ? -3.0e38f : sc[j]; if (v > best) { best = v; bi = j; } }
            mask |= 1u << bi; }
        const unsigned vm = qb >= 31 ? 0xffffffffu : ((2u << qb) - 1u);
        SELM[tid] = mask & vm;
    }
    __syncthreads();
    const unsigned selm = SELM[tq];
    unsigned anysel = SELM[lane];
#pragma unroll
    for (int o = 1; o < 64; o <<= 1) anysel |= __shfl_xor(anysel, o);
    anysel = __builtin_amdgcn_readfirstlane(anysel);
    {
        const bf16_t* kb = H + seqbase + C_KS + g * 64; const bf16_t* vb = H + seqbase + C_VS + g * 64;
        SoftState st; st.m = NEG; st.l = 0.f; st.o[0] = zero16(); st.o[1] = zero16();
        unsigned tiles = anysel; int buf = 0;
        TileRegs tr = attn_load_tile(kb, vb, __builtin_ctz(tiles), tid);
        attn_store_tile(L, tr, tid, 0); LDS_BARRIER();
        while (tiles) { const int j = __builtin_ctz(tiles); tiles &= tiles - 1;
            if (tiles) tr = attn_load_tile(kb, vb, __builtin_ctz(tiles), tid);
            const bool al = ((selm >> j) & 1u) != 0u;
            if (j == qb) attn_tile_step<1>(L, buf, qr, st, al, tq, wsf, lane); else attn_tile_step<0>(L, buf, qr, st, al, tq, wsf, lane);
            if (tiles) attn_store_tile(L, tr, tid, buf ^ 1);
            LDS_BARRIER(); buf ^= 1; }
        attn_finish_branch<1>(st, sigmoidf_(bf2f(gatep[1])), yl, wsf, lane);
    }
    {
        const bf16_t* kb = H + seqbase + C_KW + g * 64; const bf16_t* vb = H + seqbase + C_VW + g * 64;
        SoftState st; st.m = NEG; st.l = 0.f; st.o[0] = zero16(); st.o[1] = zero16();
        const int jlo = qb >= 8 ? qb - 8 : 0;
        TileRegs tr = attn_load_tile(kb, vb, jlo, tid); int buf = 0;
        attn_store_tile(L, tr, tid, 0); LDS_BARRIER();
        for (int j = jlo; j <= qb; ++j) {
            if (j < qb) tr = attn_load_tile(kb, vb, j + 1, tid);
            if (j == qb) attn_tile_step<1>(L, buf, qr, st, true, tq, wsf, lane); else if (qb - j == 8) attn_tile_step<2>(L, buf, qr, st, true, tq, wsf, lane); else attn_tile_step<0>(L, buf, qr, st, true, tq, wsf, lane);
            if (j < qb) attn_store_tile(L, tr, tid, buf ^ 1);
            LDS_BARRIER(); buf ^= 1; }
        attn_finish_branch<2>(st, sigmoidf_(bf2f(gatep[2])), yl, wsf, lane);
        bf16_t* yb = H + seqbase + (size_t)(64 * qb + 32 * (w & 1)) * HP + C_QA + (g * 4 + rh) * 64;
#pragma unroll
        for (int d0 = 0; d0 < 2; ++d0)
#pragma unroll
            for (int r = 0; r < 16; ++r) yb[(size_t)crow(r, hi) * HP + 32 * d0 + i] = (bf16_t)f2bf(st.o[d0][r]);
    }
    __syncthreads();
}

__global__ void __launch_bounds__(512, 2) nsa_hgrn_fwd(Params p) {
    extern __shared__ __attribute__((aligned(16))) unsigned char lds_raw[];
    const lptr L = (lptr)lds_raw;
    cg::grid_group grid = cg::this_grid();
    unsigned char* ws = p.ws;
    const int G = gridDim.x;
    int ph = 0;
#ifndef PH_LO
#define PH_LO 0
#endif
#ifndef PH_HI
#define PH_HI 1000
#endif
#ifndef PROBE_MASK
#define PROBE_MASK 0ull
#endif
    unsigned long long pr_t0 = 0, pr_acc = 0;
#define PHASE_BEGIN if (PROBE_MASK) pr_t0 = __builtin_amdgcn_s_memrealtime(); if (ph >= PH_LO && ph < PH_HI) {
#define PHASE_END } ++ph; if (ph > PH_LO && ph < PH_HI) grid.sync(); if (PROBE_MASK && (((unsigned long long)(PROBE_MASK) >> (ph - 1)) & 1ull)) pr_acc += __builtin_amdgcn_s_memrealtime() - pr_t0;
    bf16_t* ACT = (bf16_t*)(ws + WS_ACT); bf16_t* H = (bf16_t*)(ws + WS_H); float* Y = (float*)(ws + WS_Y);
    const float* modb = (const float*)(ws + WS_MOD);

    PHASE_BEGIN
#ifndef NO_PRO
 phase_prologue(p, L);
#endif
 PHASE_END
    PHASE_BEGIN phase_modulate(p, p.in[0], 0); PHASE_END
    for (int l = 0; l < 2; ++l) {
        const float* mod = modb + (size_t)l * 32 * 6144;
        PHASE_BEGIN
            pg8::Gemm g{ACT, (const bf16_t*)(ws + WS_WIN) + (size_t)l * NINP * 1024, NT, NINP, 1024, 1024, 1024}; pg8::StaticOrder S; S.init(NT, NINP, G, (int)blockIdx.x);
#ifndef NO_GEMM
            EpiInProj E{H, (const float*)(ws + WS_BIAS) + l * NINP, (const float*)(ws + WS_COS), (const float*)(ws + WS_SIN)};
            pg8::gemm_phase(L, g, S, E);
#endif
        PHASE_END
        PHASE_BEGIN
#ifndef NO_HGRN
            for (int u = blockIdx.x; u < 256; u += G) hgrn_unit(p, l, u, L);
#endif
#ifndef NO_CMP
            for (int u = blockIdx.x; u < 128; u += G) compress_unit(p, l, u, L);
#endif
        PHASE_END
        PHASE_BEGIN
            hgrn_norm_rows(p, l);
#ifndef NO_ATTN
            for (int u = blockIdx.x; u < 2048; u += G) { const int c = u & 255, rnd = u >> 8, s = c & 3; const int qb = (rnd & 1) ? 8 * (rnd >> 1) + 7 - s : 8 * (rnd >> 1) + s; attn_unit(p, c >> 2, qb, L); }
#endif
        PHASE_END
        PHASE_BEGIN
            pg8::Gemm g{H + C_QA, (const bf16_t*)(ws + WS_WBA) + (size_t)l * 1024 * 512, NT, 1024, 512, HP, 512}; pg8::StaticOrder S; S.init(NT, 1024, G, (int)blockIdx.x);
            EpiBranch<0> E{ACT, H + C_GMA};
#ifndef NO_G2
 pg8::gemm_phase(L, g, S, E);
#endif

        PHASE_END
        PHASE_BEGIN
            pg8::Gemm g{H + C_IB, (const bf16_t*)(ws + WS_WBB) + (size_t)l * 1024 * 512, NT, 1024, 512, HP, 512}; pg8::StaticOrder S; S.init(NT, 1024, G, (int)blockIdx.x);
            EpiBranch<1> E{ACT, H + C_GMB};
#ifndef NO_G3
 pg8::gemm_phase(L, g, S, E);
#endif

        PHASE_END
        PHASE_BEGIN
            pg8::Gemm g{ACT, (const bf16_t*)(ws + WS_WOUT) + (size_t)l * 1024 * 1024, NT, 1024, 1024, 1024, 1024}; pg8::StaticOrder S; S.init(NT, 1024, G, (int)blockIdx.x);
            EpiF32 E{Y};
#ifndef NO_G4
 pg8::gemm_phase(L, g, S, E);
#endif

        PHASE_END
        PHASE_BEGIN
            phase_ln(p, l == 0 ? p.in[0] : p.out, Y, p.out, mod + 2048, p.in[17] + l * 1024, p.in[18] + l * 1024, mod + 3072, mod + 4096);
        PHASE_END
        PHASE_BEGIN
            pg8::Gemm g{ACT, (const bf16_t*)(ws + WS_W1) + (size_t)l * 4096 * 1024, NT, FF, 1024, 1024, 1024}; pg8::StaticOrder S; S.init(NT, FF, G, (int)blockIdx.x);
            EpiRelu2 E{H};
#ifndef NO_G5
 pg8::gemm_phase(L, g, S, E);
#endif

        PHASE_END
        PHASE_BEGIN
            pg8::Gemm g{H, (const bf16_t*)(ws + WS_W2) + (size_t)l * 1024 * 4096, NT, 1024, FF, FF, FF}; pg8::StaticOrder S; S.init(NT, 1024, G, (int)blockIdx.x);
            EpiF32 E{Y};
#ifndef NO_G4
 pg8::gemm_phase(L, g, S, E);
#endif

        PHASE_END
        PHASE_BEGIN
            const float* nm = modb + (size_t)32 * 6144;
            phase_ln(p, p.out, Y, p.out, mod + 5120, p.in[21] + l * 1024, p.in[22] + l * 1024, l == 0 ? nm : nullptr, l == 0 ? nm + 1024 : nullptr);
        PHASE_END
    }
    if (PROBE_MASK) {
        if (blockIdx.x == 0) { const unsigned long long t0 = __builtin_amdgcn_s_memrealtime(); while (__builtin_amdgcn_s_memrealtime() - t0 < pr_acc) __builtin_amdgcn_s_sleep(8); }
        grid.sync();
    }
}

extern "C" void kernel_launch(void* const* d_in, const int* in_sizes, int n_in, void* d_out, int out_size, void* d_ws, size_t ws_size, hipStream_t stream) {
    static int grid = 0;
    if (grid == 0) {
        if (n_in != 23 || out_size != NT * DM || ws_size < WS_END) { fprintf(stderr, "kernel_launch: unexpected shapes (n_in %d out %d ws %zu)\n", n_in, out_size, ws_size); grid = -1; return; }
        int dev = 0, cus = 0, per_cu = 0;
        hipGetDevice(&dev); hipDeviceGetAttribute(&cus, hipDeviceAttributeMultiprocessorCount, dev);
        hipFuncSetAttribute((const void*)nsa_hgrn_fwd, hipFuncAttributeMaxDynamicSharedMemorySize, LDS_BYTES);
        hipOccupancyMaxActiveBlocksPerMultiprocessor(&per_cu, (const void*)nsa_hgrn_fwd, 512, LDS_BYTES);
        if (per_cu < 1) { fprintf(stderr, "kernel_launch: occupancy query says %d blocks per CU\n", per_cu); per_cu = 1; }
        (void)hipGetLastError();
        grid = cus;
        if (grid > 256) grid = 256;
    }
    if (grid < 0) return;
    Params p{};
    for (int i = 0; i < 23; ++i) p.in[i] = (const float*)d_in[i];
    p.out = (float*)d_out; p.ws = (unsigned char*)d_ws; p.ph_lo = 0; p.ph_hi = 1000;
    void* args[] = {&p};
    hipError_t e = hipLaunchCooperativeKernel((const void*)nsa_hgrn_fwd, dim3(grid), dim3(512), args, LDS_BYTES, stream);
    if (e != hipSuccess) fprintf(stderr, "cooperative launch failed: %s (grid %d)\n", hipGetErrorString(e), grid);
}
```

```cpp
#include <hip/hip_runtime.h>
#include <hip/hip_cooperative_groups.h>
#include <cstdio>
#include <cstdint>
namespace cg = cooperative_groups;

#define LAS __attribute__((address_space(3)))
typedef unsigned short bf16_t;
typedef short bf16x8 __attribute__((ext_vector_type(8)));
typedef short s16x4 __attribute__((ext_vector_type(4)));
typedef float f32x4 __attribute__((ext_vector_type(4)));
typedef float f32x2 __attribute__((ext_vector_type(2)));
typedef float f32x16 __attribute__((ext_vector_type(16)));
typedef unsigned u32x4 __attribute__((ext_vector_type(4)));
typedef unsigned u32x2 __attribute__((ext_vector_type(2)));
typedef LAS unsigned char* lptr;

constexpr int DM = 1024, NB = 32, SEQ = 2048, NT = NB * SEQ, FF = 4096, NIN = 5400, NINP = 5632, HP = 5400;
constexpr int C_QA = 0, C_KC = 512, C_KS = 640, C_KW = 768, C_VC = 896, C_VS = 1024, C_VW = 1152, C_GATE = 1280, C_QB = 1304, C_FB = 1816,
              C_IB = 2328, C_GB = 2840, C_GMA = 3352, C_GMB = 4376;
constexpr float QSCALE = 0.125f * 1.4426950408889634f;
constexpr float LN_EPS = 1e-5f, RMS_EPS = 1e-6f, DN_ALPHA = 1.4142135623730951f;
constexpr size_t MiB = 1u << 20;
constexpr size_t WS_MOD = 0;
constexpr size_t WS_COS = 2 * MiB;
constexpr size_t WS_SIN = 2 * MiB + 512 * 1024;
constexpr size_t WS_BIAS = 3 * MiB;
constexpr size_t WS_C1 = 3 * MiB + 256 * 1024;
constexpr size_t WS_KCC = 4 * MiB;
constexpr size_t WS_WIN = 8 * MiB;
constexpr size_t WS_WBA = 30 * MiB;
constexpr size_t WS_WBB = 32 * MiB;
constexpr size_t WS_WOUT = 34 * MiB;
constexpr size_t WS_W1 = 38 * MiB;
constexpr size_t WS_W2 = 54 * MiB;
constexpr size_t WS_CW1 = 70 * MiB;
constexpr size_t WS_CW2 = 72 * MiB;
constexpr size_t WS_ACT = 74 * MiB;
constexpr size_t WS_H = 202 * MiB;
constexpr size_t WS_Y = 714 * MiB;
constexpr size_t WS_END = 970 * MiB;
constexpr int LDS_BYTES = 147456;

struct Params {
    const float* in[23];
    float* out;
    unsigned char* ws;
    int ph_lo, ph_hi;
};

__device__ __forceinline__ unsigned f2bf(float f) { unsigned u = __builtin_bit_cast(unsigned, f); return (u + 0x7fffu + ((u >> 16) & 1u)) >> 16; }
typedef __bf16 hwbf16x2 __attribute__((ext_vector_type(2)));
__device__ __forceinline__ unsigned pk2(float lo, float hi) { f32x2 v = {lo, hi}; hwbf16x2 b = __builtin_convertvector(v, hwbf16x2); return __builtin_bit_cast(unsigned, b); }
__device__ __forceinline__ float bflo(unsigned w) { return __builtin_bit_cast(float, w << 16); }
__device__ __forceinline__ float bfhi(unsigned w) { return __builtin_bit_cast(float, w & 0xffff0000u); }
__device__ __forceinline__ float bf2f(bf16_t b) { return __builtin_bit_cast(float, (unsigned)b << 16); }
__device__ __forceinline__ float fexp(float x) { return __builtin_amdgcn_exp2f(x * 1.4426950408889634f); }
__device__ __forceinline__ float sigmoidf_(float x) { return 1.0f / (1.0f + fexp(-x)); }
#define LDS_BARRIER() asm volatile("s_waitcnt lgkmcnt(0)\n\ts_barrier" ::: "memory")
__device__ __forceinline__ int crow(int r, int hi) { return (r & 3) + 8 * (r >> 2) + 4 * hi; }
__device__ __forceinline__ int dmap(int c) { return (c >> 1) + 32 * (c & 1); }
__device__ __forceinline__ f32x16 mfma32(bf16x8 a, bf16x8 b, f32x16 c) { return __builtin_amdgcn_mfma_f32_32x32x16_bf16(a, b, c, 0, 0, 0); }
__device__ __forceinline__ f32x16 zero16() { return (f32x16){0.f,0.f,0.f,0.f,0.f,0.f,0.f,0.f,0.f,0.f,0.f,0.f,0.f,0.f,0.f,0.f}; }
__device__ __forceinline__ float wave_sum(float v) {
#pragma unroll
    for (int o = 1; o < 64; o <<= 1) v += __shfl_xor(v, o);
    return v;
}

namespace pg8 {
constexpr int BM = 256, BK = 64, HALF = 128, HTB = HALF * BK * 2, STAGE_BYTES = 8 * HTB, NXCD = 8, WGM = 8;
__host__ __device__ __forceinline__ int lds_byte(int r, int c) { const int st = (r >> 4) * 2 + (c >> 5), rr = r & 15, cc = c & 31, ob = rr * 64 + cc * 2; return st * 1024 + (ob ^ (((ob >> 9) & 1) << 5)); }
__host__ __device__ __forceinline__ void stage_rc(int b, int& R, int& C) { const int st = b / 1024, sb = b % 1024, swz = sb ^ (((sb >> 9) & 1) << 5); R = (st >> 1) * 16 + swz / 64; C = (st & 1) * 32 + (swz % 64) / 2; }
__host__ __device__ __forceinline__ int perm32(int rho) { const int n = rho >> 4, i = rho & 15; return 8 * (i >> 2) + 4 * n + (i & 3); }
struct Unit { int pm, pn; };
struct Gemm { const bf16_t* A; const bf16_t* Bt; int M, N, K, lda, ldb; };
struct StaticOrder {
    int nM, nN, nwg, G, c;
    __host__ __device__ void init(int M, int N, int G_, int c_) { nM = M / BM; nN = N / BM; nwg = nM * nN; G = G_; c = c_; }
    __host__ __device__ bool next(int i, Unit& u) const {
        const long L = (long)i * G + c; if (L >= nwg) return false;
        int wgid = (int)L; { const int q = nwg / NXCD, r = nwg % NXCD, xcd = wgid % NXCD, off = wgid / NXCD; wgid = (xcd < r ? xcd * (q + 1) : r * (q + 1) + (xcd - r) * q) + off; }
        const int nig = WGM * nN, gid = wgid / nig, fm = gid * WGM, gsz = (nM - fm) < WGM ? (nM - fm) : WGM;
        u.pm = fm + ((wgid % nig) % gsz); u.pn = (wgid % nig) / gsz; return true;
    }
};
template <class Epi>
__device__ __forceinline__ void gemm_phase(LAS unsigned char* lds, const Gemm g, const StaticOrder& S, const Epi& E) {
    int tid_ = threadIdx.x; asm volatile("" : "+v"(tid_)); const int tid = tid_, wid = __builtin_amdgcn_readfirstlane(tid >> 6), lane = tid & 63, wr = wid >> 2, wc = wid & 3, fr = lane & 15, fq = lane >> 4;
    const int K = g.K, nt = K / BK;
    unsigned voffA[2], voffB[2];
#pragma unroll
    for (int i = 0; i < 2; ++i) { int R, C; stage_rc(tid * 16 + i * 8192, R, C); const int Rb = (R & ~31) + perm32(R & 31);
        voffA[i] = (unsigned)(R * g.lda + C) * 2u; voffB[i] = (unsigned)(Rb * g.ldb + C) * 2u; }
    const size_t kstep = (size_t)(BK * 2);
    const size_t hstepA = (size_t)HALF * g.lda * 2, hstepB = (size_t)HALF * g.ldb * 2;
    const size_t tstepA = 2 * hstepA, tstepB = 2 * hstepB;
    const unsigned ldsw = (unsigned)wid * 1024u;
    const int aoff = lds_byte(wr * 64 + fr, fq * 8), boff = lds_byte(wc * 32 + fr, fq * 8);
#define PG8_SA(b, h) (((b) * 2 + (h)) * HTB)
#define PG8_SB(b, h) ((4 + (b) * 2 + (h)) * HTB)
#define PG8_STAGE(bufoff, gbase, voff) do { _Pragma("unroll") for (int _i = 0; _i < 2; ++_i) \
        __builtin_amdgcn_global_load_lds((const unsigned*)((const char*)(gbase) + (voff)[_i]), (LAS unsigned*)(lds + (bufoff) + ldsw + _i * 8192), 16, 0, 0); } while (0)
#define PG8_LDA(dst, b, h) do { _Pragma("unroll") for (int m = 0; m < 4; ++m) _Pragma("unroll") for (int k = 0; k < 2; ++k) dst[m][k] = *(const LAS bf16x8*)(lds + PG8_SA(b, h) + aoff + m * 2048 + k * 1024); } while (0)
#define PG8_LDB(dst, b, h) do { _Pragma("unroll") for (int n = 0; n < 2; ++n) _Pragma("unroll") for (int k = 0; k < 2; ++k) dst[n][k] = *(const LAS bf16x8*)(lds + PG8_SB(b, h) + boff + n * 2048 + k * 1024); } while (0)
#define PG8_MMA(ai, bj, At, Bt) do { __builtin_amdgcn_s_setprio(1); _Pragma("unroll") for (int m = 0; m < 4; ++m) _Pragma("unroll") for (int n = 0; n < 2; ++n) _Pragma("unroll") for (int k = 0; k < 2; ++k) \
        acc[ai][bj][m][n] = __builtin_amdgcn_mfma_f32_16x16x32_bf16(Bt[n][k], At[m][k], acc[ai][bj][m][n], 0, 0, 0); __builtin_amdgcn_s_setprio(0); } while (0)
#define PG8_WAIT_V(n) asm volatile("s_waitcnt vmcnt(" #n ")" ::: "memory")
#define PG8_WAIT_L(n) asm volatile("s_waitcnt lgkmcnt(" #n ")" ::: "memory")
#define PG8_BAR __builtin_amdgcn_s_barrier()
#define PG8_SCHED __builtin_amdgcn_sched_barrier(0)
    Unit cur, nxt; int ui = 0;
    if (!S.next(0, cur)) return;
    f32x4 acc[2][2][4][2];
#pragma unroll
    for (int a = 0; a < 2; ++a)
#pragma unroll
        for (int b = 0; b < 2; ++b)
#pragma unroll
            for (int m = 0; m < 4; ++m)
#pragma unroll
                for (int n = 0; n < 2; ++n) acc[a][b][m][n] = (f32x4){0.f, 0.f, 0.f, 0.f};
    bf16x8 At[4][2], B0[2][2], B1[2][2];
    const char* cA = (const char*)g.A + (size_t)cur.pm * tstepA; const char* cB = (const char*)g.Bt + (size_t)cur.pn * tstepB;
    PG8_STAGE(PG8_SB(0, 0), cB, voffB); PG8_STAGE(PG8_SB(0, 1), cB + hstepB, voffB); PG8_STAGE(PG8_SA(0, 0), cA, voffA); PG8_STAGE(PG8_SA(0, 1), cA + hstepA, voffA);
    if (wr == 1) PG8_BAR;
    PG8_WAIT_V(2); PG8_BAR;
    PG8_STAGE(PG8_SB(1, 0), cB + kstep, voffB); PG8_STAGE(PG8_SA(1, 0), cA + kstep, voffA); PG8_STAGE(PG8_SB(1, 1), cB + hstepB + kstep, voffB);
    PG8_WAIT_V(6); PG8_BAR;
    for (;;) {
        const bool has_next = S.next(ui + 1, nxt);
        const char* nA = has_next ? (const char*)g.A + (size_t)nxt.pm * tstepA : cA; const char* nB = has_next ? (const char*)g.Bt + (size_t)nxt.pn * tstepB : cB;
        for (int t = 0; t < nt; t += 2) {
            const bool last = (t == nt - 2);
            const char* a1 = cA + (size_t)(t + 1) * kstep;
            const char* a2 = last ? nA : cA + (size_t)(t + 2) * kstep; const char* b2 = last ? nB : cB + (size_t)(t + 2) * kstep;
            const char* a3 = a2 + kstep; const char* b3 = b2 + kstep;
            PG8_LDB(B0, 0, 0); PG8_LDB(B1, 0, 1); PG8_SCHED; PG8_LDA(At, 0, 0); PG8_STAGE(PG8_SA(1, 1), a1 + hstepA, voffA);
            PG8_WAIT_V(8); PG8_WAIT_L(0); PG8_BAR; PG8_MMA(0, 0, At, B0); PG8_MMA(0, 1, At, B1); PG8_BAR; PG8_SCHED;
            PG8_LDA(At, 0, 1); PG8_STAGE(PG8_SB(0, 0), b2, voffB); PG8_STAGE(PG8_SB(0, 1), b2 + hstepB, voffB); PG8_STAGE(PG8_SA(0, 0), a2, voffA);
            PG8_WAIT_V(8); PG8_WAIT_L(0); PG8_BAR; PG8_MMA(1, 0, At, B0); PG8_MMA(1, 1, At, B1); PG8_BAR; PG8_SCHED;
            PG8_LDB(B0, 1, 0); PG8_LDB(B1, 1, 1); PG8_SCHED; PG8_LDA(At, 1, 0); PG8_STAGE(PG8_SA(0, 1), a2 + hstepA, voffA);
            PG8_WAIT_V(8); PG8_WAIT_L(0); PG8_BAR; PG8_MMA(0, 0, At, B0); PG8_MMA(0, 1, At, B1); PG8_BAR; PG8_SCHED;
            PG8_LDA(At, 1, 1); PG8_STAGE(PG8_SB(1, 0), b3, voffB); PG8_STAGE(PG8_SB(1, 1), b3 + hstepB, voffB); PG8_STAGE(PG8_SA(1, 0), a3, voffA);
            PG8_WAIT_V(8); PG8_WAIT_L(0); PG8_BAR; PG8_MMA(1, 0, At, B0); PG8_MMA(1, 1, At, B1); PG8_BAR; PG8_SCHED;
        }
        if (wr == 0) PG8_BAR;
        E(acc, cur, wr, wc, fr, fq);
        if (!has_next) break;
#pragma unroll
        for (int a = 0; a < 2; ++a)
#pragma unroll
            for (int b = 0; b < 2; ++b)
#pragma unroll
                for (int m = 0; m < 4; ++m)
#pragma unroll
                    for (int n = 0; n < 2; ++n) acc[a][b][m][n] = (f32x4){0.f, 0.f, 0.f, 0.f};
        cur = nxt; cA = nA; cB = nB; ++ui;
        if (wr == 1) PG8_BAR;
    }
    PG8_WAIT_V(0);
    PG8_BAR;
#undef PG8_SA
#undef PG8_SB
#undef PG8_STAGE
#undef PG8_LDA
#undef PG8_LDB
#undef PG8_MMA
#undef PG8_WAIT_V
#undef PG8_WAIT_L
#undef PG8_BAR
#undef PG8_SCHED
}
}

typedef f32x4 AccT[2][2][4][2];
#define EPI_LOOP_BEGIN \
    const int row0 = u.pm * 256 + wr * 64 + fr, colb = u.pn * 256 + wc * 32 + 8 * fq; \
    _Pragma("unroll") for (int bj = 0; bj < 2; ++bj) { const int col = colb + bj * 128;
#define EPI_ROWS_BEGIN \
    _Pragma("unroll") for (int ai = 0; ai < 2; ++ai) { asm volatile("" ::: "memory"); _Pragma("unroll") for (int m = 0; m < 4; ++m) { const int row = row0 + ai * 128 + m * 16; \
        f32x4 v0 = acc[ai][bj][m][0], v1 = acc[ai][bj][m][1];
#define EPI_END } } }
__device__ __forceinline__ u32x4 pack8(f32x4 v0, f32x4 v1) { u32x4 w; w.x = pk2(v0[0], v0[1]); w.y = pk2(v0[2], v0[3]); w.z = pk2(v1[0], v1[1]); w.w = pk2(v1[2], v1[3]); return w; }

struct EpiInProj {
    bf16_t* H; const float* bias; const float* cosT; const float* sinT;
    __device__ __forceinline__ void operator()(const AccT& acc, const pg8::Unit& u, int wr, int wc, int fr, int fq) const {
        EPI_LOOP_BEGIN
            if (col < NIN) {
                const f32x4 b0 = *(const f32x4*)(bias + col), b1 = *(const f32x4*)(bias + col + 4);
                const bool rope = col < C_VC; const int i0 = (col & 63) >> 1; const float qs = col < C_KC ? QSCALE : 1.0f;
                EPI_ROWS_BEGIN
                    v0 = v0 + b0; v1 = v1 + b1;
                    if (rope) {
                        const int pos = row & (SEQ - 1);
                        const f32x4 c4 = *(const f32x4*)(cosT + pos * 32 + i0), s4 = *(const f32x4*)(sinT + pos * 32 + i0);
                        f32x4 o0, o1;
                        o0[0] = v0[0] * c4[0] - v0[1] * s4[0]; o0[1] = v0[1] * c4[0] + v0[0] * s4[0];
                        o0[2] = v0[2] * c4[1] - v0[3] * s4[1]; o0[3] = v0[3] * c4[1] + v0[2] * s4[1];
                        o1[0] = v1[0] * c4[2] - v1[1] * s4[2]; o1[1] = v1[1] * c4[2] + v1[0] * s4[2];
                        o1[2] = v1[2] * c4[3] - v1[3] * s4[3]; o1[3] = v1[3] * c4[3] + v1[2] * s4[3];
                        v0 = o0 * qs; v1 = o1 * qs;
                    }
                    *(u32x4*)(H + (size_t)row * HP + col) = pack8(v0, v1);
                } }
            }
        }
    }
};
__device__ __forceinline__ void sig8(u32x4 g, f32x4& s0, f32x4& s1) {
    s0[0] = sigmoidf_(bflo(g.x)); s0[1] = sigmoidf_(bfhi(g.x)); s0[2] = sigmoidf_(bflo(g.y)); s0[3] = sigmoidf_(bfhi(g.y));
    s1[0] = sigmoidf_(bflo(g.z)); s1[1] = sigmoidf_(bfhi(g.z)); s1[2] = sigmoidf_(bflo(g.w)); s1[3] = sigmoidf_(bfhi(g.w));
}
template <int SECOND> struct EpiBranch {
    bf16_t* ACT; const bf16_t* Hg;
    __device__ __forceinline__ void operator()(const AccT& acc, const pg8::Unit& u, int wr, int wc, int fr, int fq) const {
        EPI_LOOP_BEGIN
            EPI_ROWS_BEGIN
                const u32x4 g = *(const u32x4*)(Hg + (size_t)row * HP + col);
                f32x4 s0, s1; sig8(g, s0, s1);
                v0 = v0 * s0; v1 = v1 * s1;
                bf16_t* dst = ACT + (size_t)row * DM + col;
                if (SECOND) { const u32x4 p = *(const u32x4*)dst;
                    v0[0] += bflo(p.x); v0[1] += bfhi(p.x); v0[2] += bflo(p.y); v0[3] += bfhi(p.y);
                    v1[0] += bflo(p.z); v1[1] += bfhi(p.z); v1[2] += bflo(p.w); v1[3] += bfhi(p.w); }
                *(u32x4*)dst = pack8(v0, v1);
        EPI_END
    }
};
struct EpiF32 {
    bf16_t* Y;
    __device__ __forceinline__ void operator()(const AccT& acc, const pg8::Unit& u, int wr, int wc, int fr, int fq) const {
        EPI_LOOP_BEGIN
            EPI_ROWS_BEGIN
                *(u32x4*)(Y + (size_t)row * DM + col) = pack8(v0, v1);
        EPI_END
    }
};
struct EpiRelu2 {
    bf16_t* Hd;
    __device__ __forceinline__ void operator()(const AccT& acc, const pg8::Unit& u, int wr, int wc, int fr, int fq) const {
        EPI_LOOP_BEGIN
            EPI_ROWS_BEGIN
#pragma unroll
                for (int e = 0; e < 4; ++e) { const float a = fmaxf(v0[e], 0.f), b = fmaxf(v1[e], 0.f); v0[e] = a * a; v1[e] = b * b; }
                *(u32x4*)(Hd + (size_t)row * FF + col) = pack8(v0, v1);
        EPI_END
    }
};

__device__ __forceinline__ int inproj_src(int j) {
    if (j < 512) return (j & ~63) | dmap(j & 63);
    if (j < 896) { const int seg = (j - 512) >> 7, w = (j - 512) & 127; const int base = seg == 0 ? 512 : (seg == 1 ? 768 : 1024); return base + (w & 64) + dmap(w & 63); }
    if (j < 1280) { const int seg = (j - 896) >> 7, w = (j - 896) & 127; const int base = seg == 0 ? 640 : (seg == 1 ? 896 : 1152); return base + w; }
    if (j < NIN) return j;
    return -1;
}
template <int COLMODE, int ROWMODE>
__device__ __forceinline__ void transpose_item(const float* W, int N, bf16_t* WT, int Kd, LAS float* scr, int kb, int nb, int lane) {
    const int k0 = 64 * kb, n0 = 32 * nb; const int j = n0 + (lane & 31);
    int sc = j; if (COLMODE == 1) sc = inproj_src(j); if (COLMODE == 2) sc = (j & ~63) | dmap(j & 63);
    float tv[32];
#pragma unroll
    for (int i = 0; i < 32; ++i) { const int kk = 2 * i + (lane >> 5); int sr = k0 + kk; if (ROWMODE == 1) sr = (sr & ~63) | dmap(sr & 63);
        tv[i] = sc >= 0 ? W[(size_t)sr * N + sc] : 0.f; }
#pragma unroll
    for (int i = 0; i < 32; ++i) { const int kk = 2 * i + (lane >> 5); scr[kk * 33 + (lane & 31)] = tv[i]; }
    asm volatile("s_waitcnt lgkmcnt(0)" ::: "memory");
    const int c = lane & 7;
#pragma unroll
    for (int jj = 0; jj < 4; ++jj) { const int n = (lane >> 3) + 8 * jj; const LAS float* s = scr + (8 * c) * 33 + n;
        u32x4 o; o.x = pk2(s[0 * 33], s[1 * 33]); o.y = pk2(s[2 * 33], s[3 * 33]); o.z = pk2(s[4 * 33], s[5 * 33]); o.w = pk2(s[6 * 33], s[7 * 33]);
        *(u32x4*)(WT + (size_t)(n0 + n) * Kd + k0 + 8 * c) = o; }
    asm volatile("s_waitcnt lgkmcnt(0)" ::: "memory");
}

__device__ __forceinline__ void phase_prologue(const Params& p, lptr L) {
    int tid_ = threadIdx.x; asm volatile("" : "+v"(tid_)); const int tid = tid_, lane = tid & 63, wave = __builtin_amdgcn_readfirstlane(tid >> 6);
    const int G = gridDim.x;
    unsigned char* ws = p.ws;
    for (int u = blockIdx.x; u < 224; u += G) {
        if (u < 192) {
            const int l = u / 96, cc = u % 96;
            LAS float* COND = (LAS float*)L;
            for (int i = 0; i < 64; ++i) { const int e = tid + 512 * i, b = e >> 10, k = e & 1023; const float v = p.in[1][b * 1024 + k]; COND[k * 32 + b] = v * sigmoidf_(v); }
            __syncthreads();
            const float* wp = p.in[15] + (size_t)l * 1024 * 6144 + cc * 64 + lane;
            float acc[32];
#pragma unroll
            for (int b = 0; b < 32; ++b) acc[b] = 0.f;
            for (int k8 = 0; k8 < 128; k8 += 16) { float wv16[16];
#pragma unroll
                for (int q = 0; q < 16; ++q) wv16[q] = wp[(size_t)(wave * 128 + k8 + q) * 6144];
#pragma unroll
                for (int q = 0; q < 16; ++q) { const int k = wave * 128 + k8 + q; const float wv = wv16[q];
#pragma unroll
                    for (int b4 = 0; b4 < 8; ++b4) { const f32x4 c4 = *(const LAS f32x4*)(COND + k * 32 + 4 * b4);
                        acc[4 * b4 + 0] += c4[0] * wv; acc[4 * b4 + 1] += c4[1] * wv; acc[4 * b4 + 2] += c4[2] * wv; acc[4 * b4 + 3] += c4[3] * wv; } } }
            __syncthreads();
            LAS float* RED = (LAS float*)L;
#pragma unroll
            for (int b = 0; b < 32; ++b) RED[(wave * 32 + b) * 64 + lane] = acc[b];
            __syncthreads();
            float* mod = (float*)(ws + WS_MOD) + (size_t)l * 32 * 6144;
            for (int i = 0; i < 4; ++i) { const int e = tid + 512 * i, b = e >> 6, cl = e & 63; float s = 0.f;
#pragma unroll
                for (int w = 0; w < 8; ++w) s += RED[(w * 32 + b) * 64 + cl];
                mod[(size_t)b * 6144 + cc * 64 + cl] = s + p.in[16][l * 6144 + cc * 64 + cl]; }
            __syncthreads();
        } else {
            const int lk = (u - 192) >> 3, sl = (u - 192) & 7, l = lk >> 1, kv = lk & 1;
            const float* pe = p.in[kv ? 5 : 4] + l * 2048; const float* w1 = p.in[kv ? 8 : 6] + (size_t)l * 2048 * 128;
            const int ks = tid >> 7, n = tid & 127; float s = 0.f; const int kb0 = sl * 256 + ks * 64;
#pragma unroll
            for (int k4 = 0; k4 < 64; k4 += 16) { float wv16[16];
#pragma unroll
                for (int q = 0; q < 16; ++q) wv16[q] = w1[(size_t)(kb0 + k4 + q) * 128 + n];
#pragma unroll
                for (int q = 0; q < 16; ++q) s += pe[kb0 + k4 + q] * wv16[q]; }
            LAS float* RED = (LAS float*)L; RED[ks * 128 + n] = s;
            __syncthreads();
            if (tid < 128) ((float*)(ws + WS_C1))[(lk * 8 + sl) * 128 + tid] = (RED[tid] + RED[128 + tid]) + (RED[256 + tid] + RED[384 + tid]);
            __syncthreads();
        }
    }
    const int gt = blockIdx.x * 512 + tid, NGT = G * 512;
    for (int e = gt; e < SEQ * 32; e += NGT) { const int pos = e >> 5, i = e & 31;
        const float inv = 1.0f / powf(10000.0f, (float)(2 * i) / 64.0f); const float ang = (float)pos * inv;
        const double rev = (double)ang * 0.15915494309189535; const float fr = (float)(rev - floor(rev));
        ((float*)(ws + WS_COS))[e] = __builtin_amdgcn_cosf(fr); ((float*)(ws + WS_SIN))[e] = __builtin_amdgcn_sinf(fr); }
    for (int e = gt; e < 2 * NINP; e += NGT) { const int l = e / NINP, j = e % NINP; const int s = inproj_src(j); ((float*)(ws + WS_BIAS))[e] = s >= 0 ? p.in[3][l * NIN + s] : 0.f; }
    LAS float* scr = (LAS float*)(L + wave * 8448);
    const int gw = blockIdx.x * 8 + wave, NGW = G * 8;
    for (int it = gw; it < 16400; it += NGW) {
        int r = it;
        if (r < 5632) { const int l = r / 2816, q = r % 2816; transpose_item<1, 0>(p.in[2] + (size_t)l * 1024 * NIN, NIN, (bf16_t*)(ws + WS_WIN) + (size_t)l * NINP * 1024, 1024, scr, q / 176, q % 176, lane); continue; } r -= 5632;
        if (r < 512) { const int l = r / 256, q = r % 256; transpose_item<0, 0>(p.in[12] + (size_t)l * 512 * 1024, 1024, (bf16_t*)(ws + WS_WBA) + (size_t)l * 1024 * 512, 512, scr, q / 32, q % 32, lane); continue; } r -= 512;
        if (r < 512) { const int l = r / 256, q = r % 256; transpose_item<0, 0>(p.in[13] + (size_t)l * 512 * 1024, 1024, (bf16_t*)(ws + WS_WBB) + (size_t)l * 1024 * 512, 512, scr, q / 32, q % 32, lane); continue; } r -= 512;
        if (r < 1024) { const int l = r / 512, q = r % 512; transpose_item<0, 0>(p.in[14] + (size_t)l * 1024 * 1024, 1024, (bf16_t*)(ws + WS_WOUT) + (size_t)l * 1024 * 1024, 1024, scr, q / 32, q % 32, lane); continue; } r -= 1024;
        if (r < 4096) { const int l = r / 2048, q = r % 2048; transpose_item<0, 0>(p.in[19] + (size_t)l * 1024 * 4096, 4096, (bf16_t*)(ws + WS_W1) + (size_t)l * 4096 * 1024, 1024, scr, q / 128, q % 128, lane); continue; } r -= 4096;
        if (r < 4096) { const int l = r / 2048, q = r % 2048; transpose_item<0, 0>(p.in[20] + (size_t)l * 4096 * 1024, 1024, (bf16_t*)(ws + WS_W2) + (size_t)l * 1024 * 4096, 4096, scr, q / 32, q % 32, lane); continue; } r -= 4096;
        if (r < 256) { const int l = r / 128, q = r % 128; transpose_item<0, 1>(p.in[6] + (size_t)l * 2048 * 128, 128, (bf16_t*)(ws + WS_CW1) + (size_t)(l * 2 + 0) * 128 * 2048, 2048, scr, q / 4, q % 4, lane); continue; } r -= 256;
        if (r < 256) { const int l = r / 128, q = r % 128; transpose_item<0, 0>(p.in[8] + (size_t)l * 2048 * 128, 128, (bf16_t*)(ws + WS_CW1) + (size_t)(l * 2 + 1) * 128 * 2048, 2048, scr, q / 4, q % 4, lane); continue; } r -= 256;
        if (r < 8) { const int l = r / 4, q = r % 4; transpose_item<2, 0>(p.in[7] + (size_t)l * 128 * 64, 64, (bf16_t*)(ws + WS_CW2) + (size_t)(l * 2 + 0) * 64 * 128, 128, scr, q / 2, q % 2, lane); continue; } r -= 8;
        { const int l = r / 4, q = r % 4; transpose_item<0, 0>(p.in[9] + (size_t)l * 128 * 64, 64, (bf16_t*)(ws + WS_CW2) + (size_t)(l * 2 + 1) * 64 * 128, 128, scr, q / 2, q % 2, lane); }
    }
}

__device__ __forceinline__ void phase_modulate(const Params& p, const float* x, int l) {
    int tid_ = threadIdx.x; asm volatile("" : "+v"(tid_)); const int tid = tid_, lane = tid & 63, wave = tid >> 6; const int gw = blockIdx.x * 8 + wave, NGW = gridDim.x * 8;
    const float* mod = (const float*)(p.ws + WS_MOD) + (size_t)l * 32 * 6144; bf16_t* ACT = (bf16_t*)(p.ws + WS_ACT);
    for (int row = gw; row < NT; row += NGW) { const int b = row >> 11; const float* sh = mod + (size_t)b * 6144; const float* sc = sh + 1024;
#pragma unroll
        for (int j = 0; j < 4; ++j) { const int c = 4 * lane + 256 * j; const f32x4 v = *(const f32x4*)(x + (size_t)row * DM + c), a = *(const f32x4*)(sc + c), d = *(const f32x4*)(sh + c);
            const f32x4 o = v * (a + 1.0f) + d; u32x2 w; w.x = pk2(o[0], o[1]); w.y = pk2(o[2], o[3]); *(u32x2*)(ACT + (size_t)row * DM + c) = w; } }
}
__device__ __forceinline__ void phase_ln(const Params& p, const float* xin, const bf16_t* Y, float* xout, const float* gtv  ,
                                         const float* gam, const float* bet, const float* nsh  , const float* nsc) {
    int tid_ = threadIdx.x; asm volatile("" : "+v"(tid_)); const int tid = tid_, lane = tid & 63, wave = tid >> 6; const int gw = blockIdx.x * 8 + wave, NGW = gridDim.x * 8;
    bf16_t* ACT = (bf16_t*)(p.ws + WS_ACT);
    for (int row0 = 2 * gw; row0 < NT; row0 += 2 * NGW) { const int b = row0 >> 11; f32x4 v[2][4]; float s[2] = {0.f, 0.f};
#pragma unroll
        for (int q = 0; q < 2; ++q)
#pragma unroll
            for (int j = 0; j < 4; ++j) { const int c = 4 * lane + 256 * j; const size_t o = (size_t)(row0 + q) * DM + c;
                const f32x4 xv = *(const f32x4*)(xin + o), gv = *(const f32x4*)(gtv + (size_t)b * 6144 + c); const u32x2 yw = *(const u32x2*)(Y + o);
                const f32x4 yv = (f32x4){bflo(yw.x), bfhi(yw.x), bflo(yw.y), bfhi(yw.y)};
                v[q][j] = xv * DN_ALPHA + (gv + 1.0f) * yv; s[q] += (v[q][j][0] + v[q][j][1]) + (v[q][j][2] + v[q][j][3]); }
        float mean[2], rstd[2];
#pragma unroll
        for (int q = 0; q < 2; ++q) { mean[q] = wave_sum(s[q]) * (1.f / DM); float s2 = 0.f;
#pragma unroll
            for (int j = 0; j < 4; ++j) { v[q][j] = v[q][j] - mean[q]; s2 += (v[q][j][0] * v[q][j][0] + v[q][j][1] * v[q][j][1]) + (v[q][j][2] * v[q][j][2] + v[q][j][3] * v[q][j][3]); }
            rstd[q] = 1.0f / sqrtf(wave_sum(s2) * (1.f / DM) + LN_EPS); }
#pragma unroll
        for (int j = 0; j < 4; ++j) { const int c = 4 * lane + 256 * j; const f32x4 gm = *(const f32x4*)(gam + c), bt = *(const f32x4*)(bet + c);
            f32x4 a = (f32x4){0.f, 0.f, 0.f, 0.f}, d = a; if (nsh) { a = *(const f32x4*)(nsc + (size_t)b * 6144 + c); d = *(const f32x4*)(nsh + (size_t)b * 6144 + c); }
#pragma unroll
            for (int q = 0; q < 2; ++q) { const size_t o = (size_t)(row0 + q) * DM + c; const f32x4 r = v[q][j] * rstd[q] * gm + bt;
                *(f32x4*)(xout + o) = r;
                if (nsh) { const f32x4 u = r * (a + 1.0f) + d; u32x2 w; w.x = pk2(u[0], u[1]); w.y = pk2(u[2], u[3]); *(u32x2*)(ACT + o) = w; } } }
    }
}

__device__ __forceinline__ void compress_unit(const Params& p, int l, int unit, lptr L) {
    int tid_ = threadIdx.x; asm volatile("" : "+v"(tid_)); const int tid = tid_, lane = tid & 63, w = __builtin_amdgcn_readfirstlane(tid >> 6), i = lane & 31, hi = lane >> 5;
    const int bg = unit >> 1, kv = unit & 1, b = bg >> 1, g = bg & 1;
    const bf16_t* H = (const bf16_t*)(p.ws + WS_H);
    const bf16_t* src = H + (size_t)b * SEQ * HP + (kv ? C_VC : C_KC) + g * 64;
    const bf16_t* W1t = (const bf16_t*)(p.ws + WS_CW1) + (size_t)(l * 2 + kv) * 128 * 2048;
    const bf16_t* W2t = (const bf16_t*)(p.ws + WS_CW2) + (size_t)(l * 2 + kv) * 64 * 128;
    const float* c1p = (const float*)(p.ws + WS_C1) + (l * 2 + kv) * 8 * 128;
    const int mt = w & 3, nh = w >> 2;
    int nrow = 32 * mt + i; if (nrow > 126) nrow = 126;
    const bf16_t* arow = src + (size_t)(16 * nrow) * HP + 8 * hi;
    const bf16_t* b0row = W1t + (size_t)(64 * nh + i) * 2048 + 8 * hi;
    const bf16_t* b1row = b0row + 32 * 2048;
    f32x16 acc0 = zero16(), acc1 = zero16();
#pragma unroll 4
    for (int ks = 0; ks < 128; ++ks) { const int pp = ks >> 2, dc = ks & 3;
        const bf16x8 a = *(const bf16x8*)(arow + (size_t)pp * HP + dc * 16);
        const bf16x8 b0 = *(const bf16x8*)(b0row + ks * 16), b1 = *(const bf16x8*)(b1row + ks * 16);
        acc0 = mfma32(a, b0, acc0); acc1 = mfma32(a, b1, acc1); }
    LAS bf16_t* Hh = (LAS bf16_t*)L;
    { float cb0 = 0.f, cb1 = 0.f;
#pragma unroll
      for (int sl = 0; sl < 8; ++sl) { cb0 += c1p[sl * 128 + 64 * nh + i]; cb1 += c1p[sl * 128 + 64 * nh + 32 + i]; }
#pragma unroll
      for (int r = 0; r < 16; ++r) { const int row = 32 * mt + crow(r, hi); float x0 = acc0[r] + cb0, x1 = acc1[r] + cb1; x0 = x0 * sigmoidf_(x0); x1 = x1 * sigmoidf_(x1);
          Hh[row * 136 + 64 * nh + i] = (bf16_t)f2bf(x0); Hh[row * 136 + 64 * nh + 32 + i] = (bf16_t)f2bf(x1); } }
    __syncthreads();
    { const int mt2 = w & 3, nt2 = w >> 2; f32x16 acc = zero16();
#pragma unroll
      for (int ks = 0; ks < 8; ++ks) { const bf16x8 a = *(const LAS bf16x8*)(Hh + (32 * mt2 + i) * 136 + 16 * ks + 8 * hi);
          const bf16x8 bb = *(const bf16x8*)(W2t + (size_t)(32 * nt2 + i) * 128 + 16 * ks + 8 * hi); acc = mfma32(a, bb, acc); }
      bf16_t* out = (bf16_t*)(p.ws + WS_KCC) + (size_t)(kv * 64 + bg) * 128 * 64;
#pragma unroll
      for (int r = 0; r < 16; ++r) out[(32 * mt2 + crow(r, hi)) * 64 + 32 * nt2 + i] = (bf16_t)f2bf(acc[r]); }
    __syncthreads();
}

constexpr int HG_LF = 0, HG_TOT = 32768, HG_DEC = 34816, HG_QT = 35328, HG_KH = 52736, HG_KHT = 70144, HG_VT = 88576, HG_ST = 97792, HG_AM = 115200, HG_OF = 124416;
__device__ __forceinline__ void hgrn_unit(const Params& p, int l, int unit, lptr L) {
    int tid_ = threadIdx.x; asm volatile("" : "+v"(tid_)); const int tid = tid_, lane = tid & 63, w = __builtin_amdgcn_readfirstlane(tid >> 6), i = lane & 31, hi = lane >> 5;
    const int b = unit >> 3, hh = (unit >> 1) & 3, half = unit & 1;
    bf16_t* H = (bf16_t*)(p.ws + WS_H);
    const int t = tid >> 3, ds = tid & 7, d0 = ds * 16;
    LAS float* LF = (LAS float*)(L + HG_LF); LAS float* TOT = (LAS float*)(L + HG_TOT); LAS float* DEC = (LAS float*)(L + HG_DEC);
    LAS bf16_t* QT = (LAS bf16_t*)(L + HG_QT); LAS bf16_t* KH = (LAS bf16_t*)(L + HG_KH); LAS bf16_t* KHT = (LAS bf16_t*)(L + HG_KHT);
    LAS bf16_t* VT = (LAS bf16_t*)(L + HG_VT); LAS bf16_t* ST = (LAS bf16_t*)(L + HG_ST); LAS bf16_t* AM = (LAS bf16_t*)(L + HG_AM); LAS float* OF = (LAS float*)(L + HG_OF);
    float lbv[16];
#pragma unroll
    for (int e = 0; e < 16; ++e) { const int c = hh * 128 + d0 + e; lbv[e] = l == 0 ? 0.f : 1.0f / (1.0f + fexp(p.in[10][c] - p.in[10][512 + c])); }
    const int dkt = w & 3, dvt = w >> 2;
    f32x16 sacc = zero16();
    u32x4 nq0, nq1, nf0, nf1, nvv;
    { const size_t ro = (size_t)(b * SEQ + t) * HP;
      nq0 = *(const u32x4*)(H + ro + C_QB + hh * 128 + d0); nq1 = *(const u32x4*)(H + ro + C_QB + hh * 128 + d0 + 8);
      nf0 = *(const u32x4*)(H + ro + C_FB + hh * 128 + d0); nf1 = *(const u32x4*)(H + ro + C_FB + hh * 128 + d0 + 8);
      nvv = *(const u32x4*)(H + ro + C_IB + hh * 128 + half * 64 + ds * 8); }
    for (int c = 0; c < 32; ++c) {
        const size_t rowoff = (size_t)(b * SEQ + 64 * c + t) * HP;
        float qs[16], kk[16];
        {
            const u32x4 q0 = nq0, q1 = nq1, f0 = nf0, f1 = nf1, vv = nvv;
            if (c < 31) { const size_t ro = rowoff + (size_t)64 * HP;
                nq0 = *(const u32x4*)(H + ro + C_QB + hh * 128 + d0); nq1 = *(const u32x4*)(H + ro + C_QB + hh * 128 + d0 + 8);
                nf0 = *(const u32x4*)(H + ro + C_FB + hh * 128 + d0); nf1 = *(const u32x4*)(H + ro + C_FB + hh * 128 + d0 + 8);
                nvv = *(const u32x4*)(H + ro + C_IB + hh * 128 + half * 64 + ds * 8); }
            float zq[16], zf[16];
            zq[0] = bflo(q0.x); zq[1] = bfhi(q0.x); zq[2] = bflo(q0.y); zq[3] = bfhi(q0.y); zq[4] = bflo(q0.z); zq[5] = bfhi(q0.z); zq[6] = bflo(q0.w); zq[7] = bfhi(q0.w);
            zq[8] = bflo(q1.x); zq[9] = bfhi(q1.x); zq[10] = bflo(q1.y); zq[11] = bfhi(q1.y); zq[12] = bflo(q1.z); zq[13] = bfhi(q1.z); zq[14] = bflo(q1.w); zq[15] = bfhi(q1.w);
            zf[0] = bflo(f0.x); zf[1] = bfhi(f0.x); zf[2] = bflo(f0.y); zf[3] = bfhi(f0.y); zf[4] = bflo(f0.z); zf[5] = bfhi(f0.z); zf[6] = bflo(f0.w); zf[7] = bfhi(f0.w);
            zf[8] = bflo(f1.x); zf[9] = bfhi(f1.x); zf[10] = bflo(f1.y); zf[11] = bfhi(f1.y); zf[12] = bflo(f1.z); zf[13] = bfhi(f1.z); zf[14] = bflo(f1.w); zf[15] = bfhi(f1.w);
            float lf[16];
#pragma unroll
            for (int e = 0; e < 16; ++e) { qs[e] = zq[e] * sigmoidf_(zq[e]) * 0.08838834764831845f; const float f = lbv[e] + (1.0f - lbv[e]) * sigmoidf_(zf[e]); lf[e] = __logf(f); kk[e] = 1.0f - f; }
#pragma unroll
            for (int e4 = 0; e4 < 4; ++e4) *(LAS f32x4*)(LF + t * 128 + d0 + 4 * e4) = (f32x4){lf[4 * e4], lf[4 * e4 + 1], lf[4 * e4 + 2], lf[4 * e4 + 3]};
            const int dv0 = ds * 8;
            VT[(dv0 + 0) * 72 + t] = (bf16_t)(vv.x & 0xffff); VT[(dv0 + 1) * 72 + t] = (bf16_t)(vv.x >> 16); VT[(dv0 + 2) * 72 + t] = (bf16_t)(vv.y & 0xffff); VT[(dv0 + 3) * 72 + t] = (bf16_t)(vv.y >> 16);
            VT[(dv0 + 4) * 72 + t] = (bf16_t)(vv.z & 0xffff); VT[(dv0 + 5) * 72 + t] = (bf16_t)(vv.z >> 16); VT[(dv0 + 6) * 72 + t] = (bf16_t)(vv.w & 0xffff); VT[(dv0 + 7) * 72 + t] = (bf16_t)(vv.w >> 16);
        }
        LDS_BARRIER();
        {
            const int d = tid & 127, seg = tid >> 7; float cv[16];
#pragma unroll
            for (int tt = 0; tt < 16; ++tt) cv[tt] = LF[(16 * seg + tt) * 128 + d];
#pragma unroll
            for (int tt = 1; tt < 16; ++tt) cv[tt] += cv[tt - 1];
#pragma unroll
            for (int tt = 0; tt < 16; ++tt) LF[(16 * seg + tt) * 128 + d] = cv[tt];
            TOT[seg * 128 + d] = cv[15];
        }
        LDS_BARRIER();
        {
            const int seg = t >> 4;
#pragma unroll
            for (int e4 = 0; e4 < 4; ++e4) {
                const f32x4 lfv = *(const LAS f32x4*)(LF + t * 128 + d0 + 4 * e4);
                const f32x4 t0 = *(const LAS f32x4*)(TOT + d0 + 4 * e4), t1 = *(const LAS f32x4*)(TOT + 128 + d0 + 4 * e4), t2 = *(const LAS f32x4*)(TOT + 256 + d0 + 4 * e4), t3 = *(const LAS f32x4*)(TOT + 384 + d0 + 4 * e4);
                f32x4 pre = (f32x4){0.f, 0.f, 0.f, 0.f}; if (seg > 0) pre = pre + t0; if (seg > 1) pre = pre + t1; if (seg > 2) pre = pre + t2;
                const f32x4 bt = lfv + pre, bl = (t0 + t1) + (t2 + t3);
                unsigned qw[4], kw[4];
#pragma unroll
                for (int e = 0; e < 4; ++e) { const float dq = fminf(bt[e] - bl[e], 80.f); const float qv = qs[4 * e4 + e] * fexp(dq), kvv = kk[4 * e4 + e] * fexp(bl[e] - bt[e]);
                    qw[e] = f2bf(qv); kw[e] = f2bf(kvv); KHT[(d0 + 4 * e4 + e) * 72 + t] = (bf16_t)kw[e];
                    if (t == 0) DEC[d0 + 4 * e4 + e] = fexp(bl[e]); }
                *(LAS u32x2*)(QT + t * 136 + d0 + 4 * e4) = (u32x2){qw[0] | (qw[1] << 16), qw[2] | (qw[3] << 16)};
                *(LAS u32x2*)(KH + t * 136 + d0 + 4 * e4) = (u32x2){kw[0] | (kw[1] << 16), kw[2] | (kw[3] << 16)};
            }
        }
        LDS_BARRIER();
        {
#pragma unroll
            for (int r = 0; r < 16; ++r) sacc[r] *= DEC[32 * dkt + crow(r, hi)];
#pragma unroll
            for (int m = 0; m < 4; ++m) *(LAS u32x2*)(ST + (32 * dvt + i) * 136 + 32 * dkt + 8 * m + 4 * hi) = (u32x2){pk2(sacc[4 * m], sacc[4 * m + 1]), pk2(sacc[4 * m + 2], sacc[4 * m + 3])};
            if (w >= 4 && w < 7) { const int tm = (w - 4) == 0 ? 0 : 1, tn = (w - 4) == 2 ? 1 : 0; f32x16 am = zero16();
#pragma unroll
                for (int ks = 0; ks < 8; ++ks) { const bf16x8 a = *(const LAS bf16x8*)(QT + (32 * tm + i) * 136 + 16 * ks + 8 * hi), bb = *(const LAS bf16x8*)(KH + (32 * tn + i) * 136 + 16 * ks + 8 * hi); am = mfma32(a, bb, am); }
#pragma unroll
                for (int r = 0; r < 16; ++r) { const int tt = 32 * tm + crow(r, hi), ss = 32 * tn + i; AM[tt * 72 + ss] = (bf16_t)f2bf(ss <= tt ? am[r] : 0.f); } }
        }
        LDS_BARRIER();
        {
            if (w < 4) { const int mt = w & 1, nt = w >> 1; f32x16 o = zero16();
#pragma unroll
                for (int ks = 0; ks < 8; ++ks) { const bf16x8 a = *(const LAS bf16x8*)(QT + (32 * mt + i) * 136 + 16 * ks + 8 * hi), bb = *(const LAS bf16x8*)(ST + (32 * nt + i) * 136 + 16 * ks + 8 * hi); o = mfma32(a, bb, o); }
#pragma unroll
                for (int ks = 0; ks < 4; ++ks) if (ks < 2 || mt == 1) { const bf16x8 a = *(const LAS bf16x8*)(AM + (32 * mt + i) * 72 + 16 * ks + 8 * hi), bb = *(const LAS bf16x8*)(VT + (32 * nt + i) * 72 + 16 * ks + 8 * hi); o = mfma32(a, bb, o); }
#pragma unroll
                for (int r = 0; r < 16; ++r) OF[(32 * mt + crow(r, hi)) * 64 + 32 * nt + i] = o[r]; }
#pragma unroll
            for (int ks = 0; ks < 4; ++ks) { const bf16x8 a = *(const LAS bf16x8*)(KHT + (32 * dkt + i) * 72 + 16 * ks + 8 * hi), bb = *(const LAS bf16x8*)(VT + (32 * dvt + i) * 72 + 16 * ks + 8 * hi); sacc = mfma32(a, bb, sacc); }
        }
        LDS_BARRIER();
        {
            const f32x4 o0 = *(const LAS f32x4*)(OF + t * 64 + ds * 8), o1 = *(const LAS f32x4*)(OF + t * 64 + ds * 8 + 4);
            *(u32x4*)(H + rowoff + C_IB + hh * 128 + half * 64 + ds * 8) = pack8(o0, o1);
        }
    }
    __syncthreads();
}
__device__ __forceinline__ void hgrn_norm_rows(const Params& p, int l) {
    int tid_ = threadIdx.x; asm volatile("" : "+v"(tid_)); const int tid = tid_, lane = tid & 63, wave = tid >> 6; const int gw = blockIdx.x * 8 + wave, NGW = gridDim.x * 8;
    bf16_t* H = (bf16_t*)(p.ws + WS_H); const float* ng = p.in[11] + l * 128 + (lane & 15) * 8;
    const f32x4 n0 = *(const f32x4*)ng, n1 = *(const f32x4*)(ng + 4);
    for (int row0 = 4 * gw; row0 < NT; row0 += 4 * NGW) {
        u32x4 ov[4], gv[4];
#pragma unroll
        for (int q = 0; q < 4; ++q) { ov[q] = *(const u32x4*)(H + (size_t)(row0 + q) * HP + C_IB + lane * 8); gv[q] = *(const u32x4*)(H + (size_t)(row0 + q) * HP + C_GB + lane * 8); }
#pragma unroll
        for (int q = 0; q < 4; ++q) {
            float o[8] = {bflo(ov[q].x), bfhi(ov[q].x), bflo(ov[q].y), bfhi(ov[q].y), bflo(ov[q].z), bfhi(ov[q].z), bflo(ov[q].w), bfhi(ov[q].w)};
            float gg[8] = {bflo(gv[q].x), bfhi(gv[q].x), bflo(gv[q].y), bfhi(gv[q].y), bflo(gv[q].z), bfhi(gv[q].z), bflo(gv[q].w), bfhi(gv[q].w)};
            float ss = 0.f;
#pragma unroll
            for (int e = 0; e < 8; ++e) ss += o[e] * o[e];
            ss += __shfl_xor(ss, 1); ss += __shfl_xor(ss, 2); ss += __shfl_xor(ss, 4); ss += __shfl_xor(ss, 8);
            const float rs = 1.0f / sqrtf(ss * (1.0f / 128.0f) + RMS_EPS);
            f32x4 r0, r1;
#pragma unroll
            for (int e = 0; e < 4; ++e) { r0[e] = o[e] * rs * n0[e] * (gg[e] * sigmoidf_(gg[e])); r1[e] = o[4 + e] * rs * n1[e] * (gg[4 + e] * sigmoidf_(gg[4 + e])); }
            *(u32x4*)(H + (size_t)(row0 + q) * HP + C_IB + lane * 8) = pack8(r0, r1);
        }
    }
}

constexpr int AT_K = 0, AT_V = 36864, AT_IMP = 73728, AT_SEL = 106496, AT_WSF = 106752, AT_YL = 107776, AT_PITCH = 144;
struct TileRegs { u32x4 k0, k1, v0, v1; };
__device__ __forceinline__ TileRegs attn_load_tile(const bf16_t* kbase, const bf16_t* vbase, int tile, int tid) {
    TileRegs r; const size_t off = (size_t)(128 * tile + (tid >> 3)) * HP + (tid & 7) * 8;
    r.k0 = *(const u32x4*)(kbase + off); r.k1 = *(const u32x4*)(kbase + off + (size_t)64 * HP); r.v0 = *(const u32x4*)(vbase + off); r.v1 = *(const u32x4*)(vbase + off + (size_t)64 * HP); return r;
}
__device__ __forceinline__ void attn_store_tile(lptr L, const TileRegs& r, int tid, int buf) {
    const int o = buf * 18432 + (tid >> 3) * AT_PITCH + (tid & 7) * 16;
    *(LAS u32x4*)(L + AT_K + o) = r.k0; *(LAS u32x4*)(L + AT_K + o + 64 * AT_PITCH) = r.k1; *(LAS u32x4*)(L + AT_V + o) = r.v0; *(LAS u32x4*)(L + AT_V + o + 64 * AT_PITCH) = r.v1;
}
__device__ __forceinline__ void attn_qk(lptr L, int krow0, const bf16x8 (&qr)[4], f32x16& p0, f32x16& p1, int i, int hi) {
    const lptr kb = L + AT_K + (krow0 + i) * AT_PITCH + hi * 16; p0 = zero16(); p1 = zero16();
#pragma unroll
    for (int ks = 0; ks < 4; ++ks) { const bf16x8 k0 = *(const LAS bf16x8*)(kb + ks * 32), k1 = *(const LAS bf16x8*)(kb + 32 * AT_PITCH + ks * 32);
        p0 = mfma32(k0, qr[ks], p0); p1 = mfma32(k1, qr[ks], p1); }
}
__device__ __forceinline__ bf16x8 pack_p(const f32x16& p, int base) {
    u32x4 w; w.x = pk2(p[base], p[base + 1]); w.y = pk2(p[base + 2], p[base + 3]); w.z = pk2(p[base + 4], p[base + 5]); w.w = pk2(p[base + 6], p[base + 7]); return __builtin_bit_cast(bf16x8, w);
}
__device__ __forceinline__ void attn_pv16(lptr L, int vrow0, bf16x8 pa, f32x16 (&o)[2], int lane) {
    const int hi = lane >> 5;
    const lptr vb = L + AT_V + (vrow0 + 4 * hi + ((lane & 15) >> 2)) * AT_PITCH + ((lane >> 4) & 1) * 32 + (lane & 3) * 8;
#pragma unroll
    for (int d0 = 0; d0 < 2; ++d0) {
        const s16x4 lo = __builtin_bit_cast(s16x4, __builtin_amdgcn_ds_read_tr16_b64_v4i16((LAS s16x4*)(vb + d0 * 64)));
        const s16x4 up = __builtin_bit_cast(s16x4, __builtin_amdgcn_ds_read_tr16_b64_v4i16((LAS s16x4*)(vb + 8 * AT_PITCH + d0 * 64)));
        const bf16x8 bb = (bf16x8){lo[0], lo[1], lo[2], lo[3], up[0], up[1], up[2], up[3]};
        o[d0] = mfma32(pa, bb, o[d0]);
    }
}
struct SoftState { float m, l; f32x16 o[2]; };
__device__ __forceinline__ float xhalf_max(float v) { auto rr = __builtin_amdgcn_permlane32_swap(__float_as_uint(v), __float_as_uint(v), false, false); return fmaxf(__uint_as_float(rr[0]), __uint_as_float(rr[1])); }
__device__ __forceinline__ float xhalf_sum(float v) { auto rr = __builtin_amdgcn_permlane32_swap(__float_as_uint(v), __float_as_uint(v), false, false); return __uint_as_float(rr[0]) + __uint_as_float(rr[1]); }
__device__ __forceinline__ void attn_mask64(f32x16& pa, f32x16& pb, int mode, int tq, int hi) {
    const float NEG = -__builtin_inff();
    int T = tq - 4 * hi; asm volatile("" : "+v"(T));
    if (mode == 1) {
#pragma unroll
        for (int r = 0; r < 16; ++r) { const int c = (r & 3) + 8 * (r >> 2); pa[r] = (c <= T) ? pa[r] : NEG; pb[r] = (c + 32 <= T) ? pb[r] : NEG; }
    } else if (mode == 2) {
#pragma unroll
        for (int r = 0; r < 16; ++r) { const int c = (r & 3) + 8 * (r >> 2); pa[r] = (c > T) ? pa[r] : NEG; pb[r] = (c + 32 > T) ? pb[r] : NEG; }
    }
}
template <bool EDGE>
__device__ __forceinline__ void attn_step128(lptr L, int buf, const bf16x8 (&qr)[4], SoftState& st, bool alA, bool alB, int modeA, int modeB, int tq, LAS float* wsf, int lane) {
    const int i = lane & 31, hi = lane >> 5; const float NEG = -__builtin_inff();
    f32x16 p[4];
    { const lptr kb = L + AT_K + (buf * 128 + i) * AT_PITCH + hi * 16;
#pragma unroll
      for (int sb = 0; sb < 4; ++sb) p[sb] = zero16();
#pragma unroll
      for (int ks = 0; ks < 4; ++ks)
#pragma unroll
          for (int sb = 0; sb < 4; ++sb) { const bf16x8 kf = *(const LAS bf16x8*)(kb + sb * 32 * AT_PITCH + ks * 32); p[sb] = mfma32(kf, qr[ks], p[sb]); } }
    if (EDGE) { attn_mask64(p[0], p[1], modeA, tq, hi); attn_mask64(p[2], p[3], modeB, tq, hi); }
    float mA = fmaxf(p[0][0], p[1][0]), mB = fmaxf(p[2][0], p[3][0]);
#pragma unroll
    for (int r = 1; r < 16; ++r) { mA = fmaxf(mA, fmaxf(p[0][r], p[1][r])); mB = fmaxf(mB, fmaxf(p[2][r], p[3][r])); }
    float mx = fmaxf(alA ? mA : NEG, alB ? mB : NEG);
    mx = xhalf_max(mx);
    const bool need = mx > st.m + 8.0f;
    if (__any(need)) {
        const float mnew = need ? mx : st.m;
        const float alpha = need ? __builtin_amdgcn_exp2f(st.m - mnew) : 1.0f;
        st.l *= alpha; st.m = mnew;
        if (hi == 0) wsf[i] = alpha;
        asm volatile("s_waitcnt lgkmcnt(0)" ::: "memory");
#pragma unroll
        for (int r = 0; r < 16; ++r) { const float a = wsf[crow(r, hi)]; st.o[0][r] *= a; st.o[1][r] *= a; }
    }
    const float INF = __builtin_inff();
    const float subA = (alA && st.m != NEG) ? st.m : INF, subB = (alB && st.m != NEG) ? st.m : INF;
    f32x16 acc = zero16();
#pragma unroll
    for (int r = 0; r < 16; ++r) { p[0][r] = __builtin_amdgcn_exp2f(p[0][r] - subA); p[1][r] = __builtin_amdgcn_exp2f(p[1][r] - subA);
        p[2][r] = __builtin_amdgcn_exp2f(p[2][r] - subB); p[3][r] = __builtin_amdgcn_exp2f(p[3][r] - subB); }
    acc = (p[0] + p[1]) + (p[2] + p[3]);
    float rs = 0.f;
#pragma unroll
    for (int r = 0; r < 16; r += 4) rs += (acc[r] + acc[r + 1]) + (acc[r + 2] + acc[r + 3]);
    st.l += rs;
#pragma unroll
    for (int sb = 0; sb < 4; ++sb) { attn_pv16(L, buf * 128 + 32 * sb, pack_p(p[sb], 0), st.o, lane); attn_pv16(L, buf * 128 + 32 * sb + 16, pack_p(p[sb], 8), st.o, lane); }
}
template <int WHICH>
__device__ __forceinline__ void attn_finish_branch(SoftState& st, float gate, LAS unsigned* yl, LAS float* wsf, int lane) {
    const int i = lane & 31, hi = lane >> 5;
    const float lt = xhalf_sum(st.l);
    if (hi == 0) wsf[i] = gate / fmaxf(lt, 1e-30f);
    asm volatile("s_waitcnt lgkmcnt(0)" ::: "memory");
#pragma unroll
    for (int r = 0; r < 16; ++r) { const float a = wsf[crow(r, hi)];
        float y0 = st.o[0][r] * a, y1 = st.o[1][r] * a;
        if (WHICH != 0) { const unsigned w = yl[r * 64]; y0 += bflo(w); y1 += bfhi(w); }
        if (WHICH != 2) yl[r * 64] = pk2(y0, y1); else { st.o[0][r] = y0; st.o[1][r] = y1; } }
}

__device__ __forceinline__ void attn_unit(const Params& p, int bg, int qb, lptr L) {
    int tid_ = threadIdx.x; asm volatile("" : "+v"(tid_)); const int tid = tid_, lane = tid & 63, w = __builtin_amdgcn_readfirstlane(tid >> 6), i = lane & 31, hi = lane >> 5;
    const int b = bg >> 1, g = bg & 1, rh = w >> 1, tq = 32 * (w & 1) + i;
    bf16_t* H = (bf16_t*)(p.ws + WS_H);
    const size_t seqbase = (size_t)b * SEQ * HP;
    bf16_t* qrow = H + seqbase + (size_t)(64 * qb + tq) * HP;
    LAS float* wsf = (LAS float*)(L + AT_WSF) + w * 32;
    LAS float* IMP = (LAS float*)(L + AT_IMP);
    LAS unsigned* SELM = (LAS unsigned*)(L + AT_SEL);
    { const bf16_t* kc = (const bf16_t*)(p.ws + WS_KCC) + (size_t)bg * 128 * 64; const bf16_t* vc = kc + (size_t)64 * 128 * 64;
#pragma unroll
      for (int h2 = 0; h2 < 2; ++h2) { const int row = (tid >> 3) + 64 * h2, o = row * AT_PITCH + (tid & 7) * 16;
          *(LAS u32x4*)(L + AT_K + o) = *(const u32x4*)(kc + row * 64 + (tid & 7) * 8); *(LAS u32x4*)(L + AT_V + o) = *(const u32x4*)(vc + row * 64 + (tid & 7) * 8); } }
    bf16x8 qr[4];
#pragma unroll
    for (int ks = 0; ks < 4; ++ks) qr[ks] = *(const bf16x8*)(qrow + C_QA + (g * 4 + rh) * 64 + 16 * ks + 8 * hi);
    const bf16_t* gatep = qrow + C_GATE + (g * 4 + rh) * 3;
    LAS unsigned* yl = (LAS unsigned*)(L + AT_YL) + w * 1024 + lane;
    const float NEG = -__builtin_inff();
    __syncthreads();
    {
        f32x16 pc[4];
        attn_qk(L, 0, qr, pc[0], pc[1], i, hi); attn_qk(L, 64, qr, pc[2], pc[3], i, hi);
        const int tpos = 64 * qb + tq; float mx = NEG;
#pragma unroll
        for (int kt = 0; kt < 4; ++kt)
#pragma unroll
            for (int r = 0; r < 16; ++r) { const int n = 32 * kt + crow(r, hi); pc[kt][r] = (16 * n + 31 <= tpos) ? pc[kt][r] : NEG; mx = fmaxf(mx, pc[kt][r]); }
        mx = fmaxf(mx, __shfl_xor(mx, 32)); const float muse = (mx == NEG) ? 0.f : mx; float rs = 0.f;
#pragma unroll
        for (int kt = 0; kt < 4; ++kt)
#pragma unroll
            for (int r = 0; r < 16; ++r) { pc[kt][r] = __builtin_amdgcn_exp2f(pc[kt][r] - muse); rs += pc[kt][r]; }
        rs += __shfl_xor(rs, 32); const float inv = 1.0f / fmaxf(rs, 1e-30f);
        float prev = 0.f;
#pragma unroll
        for (int kt = 0; kt < 4; ++kt) {
#pragma unroll
            for (int r = 0; r < 16; ++r) pc[kt][r] *= inv;
#pragma unroll
            for (int m = 0; m < 4; ++m) { const float G4 = (pc[kt][4 * m] + pc[kt][4 * m + 1]) + (pc[kt][4 * m + 2] + pc[kt][4 * m + 3]); const float yy = __shfl_xor(pc[kt][4 * m + 3], 32);
                const float val = hi ? (G4 + yy) : (G4 + prev); prev = yy; IMP[(rh * 64 + tq) * 32 + 8 * kt + 2 * m + hi] = val; } }
        SoftState sc; sc.m = 0.f; sc.l = 0.5f;   sc.o[0] = zero16(); sc.o[1] = zero16();
#pragma unroll
        for (int kt = 0; kt < 4; ++kt) { attn_pv16(L, 32 * kt, pack_p(pc[kt], 0), sc.o, lane); attn_pv16(L, 32 * kt + 16, pack_p(pc[kt], 8), sc.o, lane); }
        attn_finish_branch<0>(sc, sigmoidf_(bf2f(gatep[0])), yl, wsf, lane);
    }
    __syncthreads();
    if (tid < 64) {
        float sc[32];
#pragma unroll
        for (int j = 0; j < 32; ++j) { if ((j & 7) == 0) asm volatile("" ::: "memory"); const float s = (IMP[(0 * 64 + tid) * 32 + j] + IMP[(1 * 64 + tid) * 32 + j]) + (IMP[(2 * 64 + tid) * 32 + j] + IMP[(3 * 64 + tid) * 32 + j]);
            const bool valid = j <= qb, forced = valid && (j == 0 || j == qb || j == qb - 1); sc[j] = forced ? 1.0e4f : (valid ? s : -1.0f); }
        unsigned mask = 0u;
#pragma unroll
        for (int it = 0; it < 8; ++it) { float best = -3.0e38f; int bi = 0;
#pragma unroll
            for (int j = 0; j < 32; ++j) { const float v = ((mask >> j) & 1u) ? -3.0e38f : sc[j]; if (v > best) { best = v; bi = j; } }
            mask |= 1u << bi; }
        const unsigned vm = qb >= 31 ? 0xffffffffu : ((2u << qb) - 1u);
        SELM[tid] = mask & vm;
    }
    __syncthreads();
    const unsigned selm = SELM[tq];
    unsigned anysel = SELM[lane];
#pragma unroll
    for (int o = 1; o < 64; o <<= 1) anysel |= __shfl_xor(anysel, o);
    anysel = __builtin_amdgcn_readfirstlane(anysel);
    {
        const bf16_t* kb = H + seqbase + C_KS + g * 64; const bf16_t* vb = H + seqbase + C_VS + g * 64;
        SoftState st; st.m = NEG; st.l = 0.f; st.o[0] = zero16(); st.o[1] = zero16();
        unsigned tiles = 0u; int buf = 0;
        for (int J = 0; J <= (qb >> 1); ++J) if ((anysel >> (2 * J)) & 3u) tiles |= 1u << J;
        const int JD = qb >> 1;
        TileRegs tr = attn_load_tile(kb, vb, __builtin_ctz(tiles), tid);
        attn_store_tile(L, tr, tid, 0); LDS_BARRIER();
        while (tiles) { const int J = __builtin_ctz(tiles); tiles &= tiles - 1;
            if (tiles) tr = attn_load_tile(kb, vb, __builtin_ctz(tiles), tid);
            const bool alA = ((selm >> (2 * J)) & 1u) != 0u, alB = ((selm >> (2 * J + 1)) & 1u) != 0u;
            if (J == JD) attn_step128<true>(L, buf, qr, st, alA, alB, (qb & 1) ? 0 : 1, (qb & 1) ? 1 : 0, tq, wsf, lane);
            else attn_step128<false>(L, buf, qr, st, alA, alB, 0, 0, tq, wsf, lane);
            if (tiles) attn_store_tile(L, tr, tid, buf ^ 1);
            LDS_BARRIER(); buf ^= 1; }
        attn_finish_branch<1>(st, sigmoidf_(bf2f(gatep[1])), yl, wsf, lane);
    }
    {
        const bf16_t* kb = H + seqbase + C_KW + g * 64; const bf16_t* vb = H + seqbase + C_VW + g * 64;
        SoftState st; st.m = NEG; st.l = 0.f; st.o[0] = zero16(); st.o[1] = zero16();
        const int jlo = qb >= 8 ? qb - 8 : 0; const int J0 = jlo >> 1, J1 = qb >> 1; int buf = 0;
        TileRegs tr = attn_load_tile(kb, vb, J0, tid);
        attn_store_tile(L, tr, tid, 0); LDS_BARRIER();
        for (int J = J0; J <= J1; ++J) {
            if (J < J1) tr = attn_load_tile(kb, vb, J + 1, tid);
            const int ja = 2 * J, jb2 = 2 * J + 1;
            const bool alA = ja >= jlo && ja <= qb, alB = jb2 >= jlo && jb2 <= qb;
            const int mA = ja == qb ? 1 : (qb - ja == 8 ? 2 : 0), mB = jb2 == qb ? 1 : (qb - jb2 == 8 ? 2 : 0);
            if (!alA || !alB || mA || mB) attn_step128<true>(L, buf, qr, st, alA, alB, mA, mB, tq, wsf, lane);
            else attn_step128<false>(L, buf, qr, st, true, true, 0, 0, tq, wsf, lane);
            if (J < J1) attn_store_tile(L, tr, tid, buf ^ 1);
            LDS_BARRIER(); buf ^= 1; }
        attn_finish_branch<2>(st, sigmoidf_(bf2f(gatep[2])), yl, wsf, lane);
        bf16_t* yb = H + seqbase + (size_t)(64 * qb + 32 * (w & 1)) * HP + C_QA + (g * 4 + rh) * 64;
#pragma unroll
        for (int d0 = 0; d0 < 2; ++d0)
#pragma unroll
            for (int r = 0; r < 16; ++r) yb[(size_t)crow(r, hi) * HP + 32 * d0 + i] = (bf16_t)f2bf(st.o[d0][r]);
    }
    __syncthreads();
}

__global__ void __launch_bounds__(512, 2) nsa_hgrn_fwd(Params p) {
    extern __shared__ __attribute__((aligned(16))) unsigned char lds_raw[];
    const lptr L = (lptr)lds_raw;
    cg::grid_group grid = cg::this_grid();
    unsigned char* ws = p.ws;
    const int G = gridDim.x;
    int ph = 0;
#ifndef PH_LO
#define PH_LO 0
#endif
#ifndef PH_HI
#define PH_HI 1000
#endif
#ifndef PROBE_MASK
#define PROBE_MASK 0ull
#endif
    unsigned long long pr_t0 = 0, pr_acc = 0;
#define PHASE_BEGIN if (PROBE_MASK) pr_t0 = __builtin_amdgcn_s_memrealtime(); if (ph >= PH_LO && ph < PH_HI) {
#define PHASE_END } ++ph; if (ph > PH_LO && ph < PH_HI) grid.sync(); if (PROBE_MASK && (((unsigned long long)(PROBE_MASK) >> (ph - 1)) & 1ull)) pr_acc += __builtin_amdgcn_s_memrealtime() - pr_t0;
    bf16_t* ACT = (bf16_t*)(ws + WS_ACT); bf16_t* H = (bf16_t*)(ws + WS_H); bf16_t* Y = (bf16_t*)(ws + WS_Y);
    const float* modb = (const float*)(ws + WS_MOD);

    PHASE_BEGIN
#ifndef NO_PRO
 phase_prologue(p, L);
#endif
 PHASE_END
    PHASE_BEGIN phase_modulate(p, p.in[0], 0); PHASE_END
    for (int l = 0; l < 2; ++l) {
        const float* mod = modb + (size_t)l * 32 * 6144;
        PHASE_BEGIN
            pg8::Gemm g{ACT, (const bf16_t*)(ws + WS_WIN) + (size_t)l * NINP * 1024, NT, NINP, 1024, 1024, 1024}; pg8::StaticOrder S; S.init(NT, NINP, G, (int)blockIdx.x);
#ifndef NO_GEMM
            EpiInProj E{H, (const float*)(ws + WS_BIAS) + l * NINP, (const float*)(ws + WS_COS), (const float*)(ws + WS_SIN)};
            pg8::gemm_phase(L, g, S, E);
#endif
        PHASE_END
        PHASE_BEGIN
#ifndef NO_HGRN
            for (int u = blockIdx.x; u < 256; u += G) hgrn_unit(p, l, u, L);
#endif
#ifndef NO_CMP
            for (int u = blockIdx.x; u < 128; u += G) compress_unit(p, l, u, L);
#endif
        PHASE_END
        PHASE_BEGIN
            hgrn_norm_rows(p, l);
#ifndef NO_ATTN
            for (int u = blockIdx.x; u < 2048; u += G) { const int c = u & 255, rnd = u >> 8, s = c & 3; const int qb = (rnd & 1) ? 8 * (rnd >> 1) + 7 - s : 8 * (rnd >> 1) + s; attn_unit(p, c >> 2, qb, L); }
#endif
        PHASE_END
        PHASE_BEGIN
            pg8::Gemm g{H + C_QA, (const bf16_t*)(ws + WS_WBA) + (size_t)l * 1024 * 512, NT, 1024, 512, HP, 512}; pg8::StaticOrder S; S.init(NT, 1024, G, (int)blockIdx.x);
            EpiBranch<0> E{ACT, H + C_GMA};
#ifndef NO_G2
 pg8::gemm_phase(L, g, S, E);
#endif

        PHASE_END
        PHASE_BEGIN
            pg8::Gemm g{H + C_IB, (const bf16_t*)(ws + WS_WBB) + (size_t)l * 1024 * 512, NT, 1024, 512, HP, 512}; pg8::StaticOrder S; S.init(NT, 1024, G, (int)blockIdx.x);
            EpiBranch<1> E{ACT, H + C_GMB};
#ifndef NO_G3
 pg8::gemm_phase(L, g, S, E);
#endif

        PHASE_END
        PHASE_BEGIN
            pg8::Gemm g{ACT, (const bf16_t*)(ws + WS_WOUT) + (size_t)l * 1024 * 1024, NT, 1024, 1024, 1024, 1024}; pg8::StaticOrder S; S.init(NT, 1024, G, (int)blockIdx.x);
            EpiF32 E{Y};
#ifndef NO_G4
 pg8::gemm_phase(L, g, S, E);
#endif

        PHASE_END
        PHASE_BEGIN
            phase_ln(p, l == 0 ? p.in[0] : p.out, Y, p.out, mod + 2048, p.in[17] + l * 1024, p.in[18] + l * 1024, mod + 3072, mod + 4096);
        PHASE_END
        PHASE_BEGIN
            pg8::Gemm g{ACT, (const bf16_t*)(ws + WS_W1) + (size_t)l * 4096 * 1024, NT, FF, 1024, 1024, 1024}; pg8::StaticOrder S; S.init(NT, FF, G, (int)blockIdx.x);
            EpiRelu2 E{H};
#ifndef NO_G5
 pg8::gemm_phase(L, g, S, E);
#endif

        PHASE_END
        PHASE_BEGIN
            pg8::Gemm g{H, (const bf16_t*)(ws + WS_W2) + (size_t)l * 1024 * 4096, NT, 1024, FF, FF, FF}; pg8::StaticOrder S; S.init(NT, 1024, G, (int)blockIdx.x);
            EpiF32 E{Y};
#ifndef NO_G4
 pg8::gemm_phase(L, g, S, E);
#endif

        PHASE_END
        PHASE_BEGIN
            const float* nm = modb + (size_t)32 * 6144;
            phase_ln(p, p.out, Y, p.out, mod + 5120, p.in[21] + l * 1024, p.in[22] + l * 1024, l == 0 ? nm : nullptr, l == 0 ? nm + 1024 : nullptr);
        PHASE_END
    }
    if (PROBE_MASK) {
        if (blockIdx.x == 0) { const unsigned long long t0 = __builtin_amdgcn_s_memrealtime(); while (__builtin_amdgcn_s_memrealtime() - t0 < pr_acc) __builtin_amdgcn_s_sleep(8); }
        grid.sync();
    }
}

extern "C" void kernel_launch(void* const* d_in, const int* in_sizes, int n_in, void* d_out, int out_size, void* d_ws, size_t ws_size, hipStream_t stream) {
    static int grid = 0;
    if (grid == 0) {
        if (n_in != 23 || out_size != NT * DM || ws_size < WS_END) { fprintf(stderr, "kernel_launch: unexpected shapes (n_in %d out %d ws %zu)\n", n_in, out_size, ws_size); grid = -1; return; }
        int dev = 0, cus = 0, per_cu = 0;
        hipGetDevice(&dev); hipDeviceGetAttribute(&cus, hipDeviceAttributeMultiprocessorCount, dev);
        hipFuncSetAttribute((const void*)nsa_hgrn_fwd, hipFuncAttributeMaxDynamicSharedMemorySize, LDS_BYTES);
        hipOccupancyMaxActiveBlocksPerMultiprocessor(&per_cu, (const void*)nsa_hgrn_fwd, 512, LDS_BYTES);
        if (per_cu < 1) { fprintf(stderr, "kernel_launch: occupancy query says %d blocks per CU\n", per_cu); per_cu = 1; }
        (void)hipGetLastError();
        grid = cus;
        if (grid > 256) grid = 256;
    }
    if (grid < 0) return;
    Params p{};
    for (int i = 0; i < 23; ++i) p.in[i] = (const float*)d_in[i];
    p.out = (float*)d_out; p.ws = (unsigned char*)d_ws; p.ph_lo = 0; p.ph_hi = 1000;
    void* args[] = {&p};
    hipError_t e = hipLaunchCooperativeKernel((const void*)nsa_hgrn_fwd, dim3(grid), dim3(512), args, LDS_BYTES, stream);
    if (e != hipSuccess) fprintf(stderr, "cooperative launch failed: %s (grid %d)\n", hipGetErrorString(e), grid);
}
```
